# Optimizing an MI355X kernel written in HIP

```python
import math
import jax, jax.numpy as jnp
from jax import lax
import numpy as np

D_MODEL = 2048
BATCH = 4
SEQ = 4096
DEPTH = 1

CHUNK = 64
Q_BLOCK = 128
RET_HEADS = 8
RET_QK_DIM = 128
RET_V_DIM = 256
RET_THETA = 10000.0
DIFF_HEADS = 8
DIFF_QK_DIM = 128
DIFF_V_DIM = 256
ROPE_THETA = 500000.0
ROPE_DIM = DIFF_QK_DIM // 4
N_GROUPS = 4
EXPERTS_PER_GROUP = 8
N_EXPERTS = N_GROUPS * EXPERTS_PER_GROUP
TOP_K = 2
EXPERT_FF = 1024
MOE_BLOCK = 256
LN_EPS = 1e-5
DEEPNORM_ALPHA = (2 * DEPTH) ** 0.25
DEEPNORM_BETA = (8 * DEPTH) ** -0.25
RET_Q_W = RET_HEADS * RET_QK_DIM
RET_V_W = RET_HEADS * RET_V_DIM
DIFF_QK_W = 2 * DIFF_HEADS * DIFF_QK_DIM
DIFF_V_W = DIFF_HEADS * DIFF_V_DIM
IN_SIZES = (RET_Q_W, RET_Q_W, RET_V_W, RET_V_W, DIFF_QK_W, DIFF_QK_W, DIFF_V_W, 2 * D_MODEL)
N_IN = sum(IN_SIZES)

kernel_name = "hybrid_retention_diffattn_hmoe_deepnorm"


def layer_norm(x, gain, bias=None, eps=LN_EPS):
    xf = x.astype(jnp.float32)
    mu = jnp.mean(xf, axis=-1, keepdims=True)
    var = jnp.mean(jnp.square(xf - mu), axis=-1, keepdims=True)
    y = (xf - mu) * lax.rsqrt(var + eps) * gain
    if bias is not None:
        y = y + bias
    return y.astype(x.dtype)


def rms_norm(x, gain, eps=LN_EPS):
    xf = x.astype(jnp.float32)
    y = xf * lax.rsqrt(jnp.mean(jnp.square(xf), axis=-1, keepdims=True) + eps) * gain
    return y.astype(x.dtype)


def rope_angles(positions, dim, theta):
    inv_freq = 1.0 / (theta ** (jnp.arange(0, dim, 2, dtype=jnp.float32) / dim))
    ang = positions.astype(jnp.float32)[..., None] * inv_freq
    return jnp.cos(ang), jnp.sin(ang)


def rotate(x, cos, sin):
    half = x.shape[-1] // 2
    x1, x2 = x[..., :half], x[..., half:]
    return jnp.concatenate([x1 * cos - x2 * sin, x2 * cos + x1 * sin], axis=-1)


def retention(q, k, v, positions):
    B, S, H, dk = q.shape
    dv = v.shape[-1]
    nc = S // CHUNK
    cos, sin = rope_angles(positions, dk, RET_THETA)
    cos, sin = cos[:, :, None, :], sin[:, :, None, :]
    q = rotate(q.astype(jnp.float32), cos, sin)
    k = rotate(k.astype(jnp.float32), cos, sin) * (dk ** -0.5)
    v = v.astype(jnp.float32)
    log_gamma = jnp.log(1.0 - 2.0 ** (-5.0 - jnp.arange(H, dtype=jnp.float32)))
    idx = jnp.arange(CHUNK, dtype=jnp.float32)
    intra_decay = jnp.exp(log_gamma[:, None, None] * jnp.abs(idx[:, None] - idx[None, :]))
    q_decay = jnp.exp(log_gamma[:, None] * (idx + 1.0))
    k_decay = jnp.exp(log_gamma[:, None] * (CHUNK - 1.0 - idx))
    chunk_decay = jnp.exp(log_gamma * CHUNK)

    def to_chunks(t):
        return t.reshape(B, nc, CHUNK, H, t.shape[-1]).transpose(1, 0, 3, 2, 4)

    qc, kc, vc = to_chunks(q), to_chunks(k), to_chunks(v)
    scores = jnp.einsum('nbhcd,nbhkd->nbhck', qc, kc) * intra_decay[None, None]
    intra = jnp.einsum('nbhck,nbhke->nbhce', scores, vc)

    def step(state, xs):
        qi, ki, vi = xs
        cross = jnp.einsum('bhcd,bhde->bhce', qi * q_decay[None, :, :, None], state)
        state = state * chunk_decay[None, :, None, None] + jnp.einsum(
            'bhcd,bhce->bhde', ki * k_decay[None, :, :, None], vi)
        return state, cross

    state0 = jnp.zeros((B, H, dk, dv), jnp.float32)
    _, cross = lax.scan(step, state0, (qc, kc, vc))
    out = intra + cross
    return out.transpose(1, 0, 3, 2, 4).reshape(B, S, H, dv)


def diff_attention(q, k, v, positions, lam, lambda_init, subln_gain):
    B, S, H, _, d = q.shape
    cos, sin = rope_angles(positions, ROPE_DIM, ROPE_THETA)
    cos, sin = cos[:, :, None, None, :], sin[:, :, None, None, :]

    def partial_rope(t):
        tr = rotate(t[..., :ROPE_DIM].astype(jnp.float32), cos, sin).astype(t.dtype)
        return jnp.concatenate([tr, t[..., ROPE_DIM:]], axis=-1)

    qh = partial_rope(q).transpose(0, 2, 3, 1, 4)
    kh = partial_rope(k).transpose(0, 2, 3, 1, 4)
    vh = v.transpose(0, 2, 1, 3)
    scale = d ** -0.5
    chunk_id = np.arange(S) // CHUNK
    outs = []
    for start in range(0, S, Q_BLOCK):
        end = start + Q_BLOCK
        s = jnp.einsum('bhiqd,bhikd->bhiqk', qh[:, :, :, start:end], kh[:, :, :, :end],
                       preferred_element_type=jnp.float32) * scale
        mask = chunk_id[start:end, None] >= chunk_id[None, :end]
        p = jax.nn.softmax(jnp.where(mask, s, -jnp.inf), axis=-1)
        a = p[:, :, 0] - lam * p[:, :, 1]
        outs.append(jnp.einsum('bhqk,bhke->bhqe', a.astype(vh.dtype), vh[:, :, :end]))
    o = jnp.concatenate(outs, axis=2)
    o = rms_norm(o, subln_gain) * (1.0 - lambda_init)
    return o.transpose(0, 2, 1, 3)


def mixer_sublayer(x, positions, w_in, ret_gn_gain, lq1, lk1, lq2, lk2, subln_gain,
                   w_ret_proj, w_diff_proj, w_out, lambda_init):
    B, S, _ = x.shape
    u = x @ w_in
    cuts = list(np.cumsum(IN_SIZES)[:-1])
    rq, rk, rv, rg, dq, dk, dvv, gates = jnp.split(u, cuts, axis=-1)
    ret = retention(rq.reshape(B, S, RET_HEADS, RET_QK_DIM), rk.reshape(B, S, RET_HEADS, RET_QK_DIM),
                    rv.reshape(B, S, RET_HEADS, RET_V_DIM), positions)
    ret = layer_norm(ret, ret_gn_gain).astype(x.dtype).reshape(B, S, RET_V_W) * jax.nn.silu(rg)
    lam = (jnp.exp(jnp.sum(lq1.astype(jnp.float32) * lk1.astype(jnp.float32)))
           - jnp.exp(jnp.sum(lq2.astype(jnp.float32) * lk2.astype(jnp.float32))) + lambda_init)
    diff = diff_attention(dq.reshape(B, S, DIFF_HEADS, 2, DIFF_QK_DIM),
                          dk.reshape(B, S, DIFF_HEADS, 2, DIFF_QK_DIM),
                          dvv.reshape(B, S, DIFF_HEADS, DIFF_V_DIM), positions, lam, lambda_init, subln_gain)
    diff = diff.reshape(B, S, DIFF_V_W)
    g_ret, g_diff = jnp.split(gates, 2, axis=-1)
    merged = jax.nn.sigmoid(g_ret) * (ret @ w_ret_proj) + jax.nn.sigmoid(g_diff) * (diff @ w_diff_proj)
    return merged @ w_out


def hierarchical_moe(h, w_group, b_group, w_router, b_router, w_gate, w_up, w_down):
    B, S, D = h.shape
    xt = h.reshape(-1, D)
    n_tok = xt.shape[0]
    group_prob = jax.nn.softmax((xt @ w_group + b_group).astype(jnp.float32), axis=-1)
    g = jnp.argmax(group_prob, axis=-1)
    p_g = jnp.take_along_axis(group_prob, g[:, None], axis=1)[:, 0]
    exp_logits = (xt @ w_router + b_router).astype(jnp.float32).reshape(n_tok, N_GROUPS, EXPERTS_PER_GROUP)
    within = jnp.take_along_axis(exp_logits, g[:, None, None], axis=1)[:, 0]
    top_vals, top_idx = lax.top_k(within, TOP_K)
    weights = (jax.nn.softmax(top_vals, axis=-1) * p_g[:, None]).reshape(-1)
    expert_ids = (g[:, None] * EXPERTS_PER_GROUP + top_idx).reshape(-1).astype(jnp.int32)
    token_ids = jnp.repeat(jnp.arange(n_tok, dtype=jnp.int32), TOP_K)
    n_assign = n_tok * TOP_K
    order = jnp.argsort(expert_ids)
    sorted_e = expert_ids[order]
    counts = jax.ops.segment_sum(jnp.ones((n_assign,), jnp.int32), expert_ids, num_segments=N_EXPERTS)
    padded = (counts + MOE_BLOCK - 1) // MOE_BLOCK * MOE_BLOCK
    pad_end = jnp.cumsum(padded)
    pad_start = pad_end - padded
    start = jnp.cumsum(counts) - counts
    dest = pad_start[sorted_e] + jnp.arange(n_assign, dtype=jnp.int32) - start[sorted_e]
    n_slots = -(-n_assign // MOE_BLOCK) * MOE_BLOCK + N_EXPERTS * MOE_BLOCK
    n_blocks = n_slots // MOE_BLOCK
    slot_token = jnp.zeros((n_slots,), jnp.int32).at[dest].set(token_ids[order])
    slot_weight = jnp.zeros((n_slots,), jnp.float32).at[dest].set(weights[order])
    block_expert = jnp.minimum(
        jnp.searchsorted(pad_end, jnp.arange(n_blocks, dtype=jnp.int32) * MOE_BLOCK, side='right'),
        N_EXPERTS - 1)
    xb = xt[slot_token].reshape(n_blocks, MOE_BLOCK, D)

    def expert_block(args):
        xblk, e = args
        return (jax.nn.silu(xblk @ w_gate[e]) * (xblk @ w_up[e])) @ w_down[e]

    yb = lax.map(expert_block, (xb, block_expert)).reshape(n_slots, D)
    y = jnp.zeros((n_tok, D), jnp.float32).at[slot_token].add(yb.astype(jnp.float32) * slot_weight[:, None])
    return y.astype(h.dtype).reshape(B, S, D)


def setup_inputs(seed: int = 0) -> dict:
    key = jax.random.key(seed)
    ks = jax.random.split(key, 24)
    f32 = jnp.float32
    nrm = lambda k, shape, s: jax.random.normal(k, shape, f32) * s
    start = jax.random.randint(ks[1], (BATCH, 1), 0, 8192, dtype=jnp.int32)
    return {
        "x": nrm(ks[0], (BATCH, SEQ, D_MODEL), 1.0),
        "positions": start + jnp.arange(SEQ, dtype=jnp.int32)[None, :],
        "w_in": nrm(ks[2], (DEPTH, D_MODEL, N_IN), D_MODEL ** -0.5),
        "ret_gn_gain": 1.0 + nrm(ks[3], (DEPTH, RET_HEADS, RET_V_DIM), 0.02),
        "diff_lambda_q1": nrm(ks[4], (DEPTH, DIFF_QK_DIM), 0.1),
        "diff_lambda_k1": nrm(ks[5], (DEPTH, DIFF_QK_DIM), 0.1),
        "diff_lambda_q2": nrm(ks[6], (DEPTH, DIFF_QK_DIM), 0.1),
        "diff_lambda_k2": nrm(ks[7], (DEPTH, DIFF_QK_DIM), 0.1),
        "diff_subln_gain": 1.0 + nrm(ks[8], (DEPTH, DIFF_V_DIM), 0.02),
        "w_ret_proj": nrm(ks[9], (DEPTH, RET_V_W, D_MODEL), RET_V_W ** -0.5 * DEEPNORM_BETA),
        "w_diff_proj": nrm(ks[10], (DEPTH, DIFF_V_W, D_MODEL), DIFF_V_W ** -0.5 * DEEPNORM_BETA),
        "w_out": nrm(ks[11], (DEPTH, D_MODEL, D_MODEL), D_MODEL ** -0.5 * DEEPNORM_BETA),
        "ln1_gain": 1.0 + nrm(ks[12], (DEPTH, D_MODEL), 0.02),
        "ln1_bias": nrm(ks[13], (DEPTH, D_MODEL), 0.02),
        "w_group": nrm(ks[14], (DEPTH, D_MODEL, N_GROUPS), D_MODEL ** -0.5),
        "b_group": nrm(ks[15], (DEPTH, N_GROUPS), 0.01),
        "w_router": nrm(ks[16], (DEPTH, D_MODEL, N_EXPERTS), D_MODEL ** -0.5),
        "b_router": nrm(ks[17], (DEPTH, N_EXPERTS), 0.01),
        "w_expert_gate": nrm(ks[18], (DEPTH, N_EXPERTS, D_MODEL, EXPERT_FF), D_MODEL ** -0.5),
        "w_expert_up": nrm(ks[19], (DEPTH, N_EXPERTS, D_MODEL, EXPERT_FF), D_MODEL ** -0.5),
        "w_expert_down": nrm(ks[20], (DEPTH, N_EXPERTS, EXPERT_FF, D_MODEL), EXPERT_FF ** -0.5 * DEEPNORM_BETA),
        "ln2_gain": 1.0 + nrm(ks[21], (DEPTH, D_MODEL), 0.02),
        "ln2_bias": nrm(ks[22], (DEPTH, D_MODEL), 0.02),
    }


def reference(x, positions, w_in, ret_gn_gain, diff_lambda_q1, diff_lambda_k1, diff_lambda_q2,
              diff_lambda_k2, diff_subln_gain, w_ret_proj, w_diff_proj, w_out, ln1_gain, ln1_bias,
              w_group, b_group, w_router, b_router, w_expert_gate, w_expert_up, w_expert_down,
              ln2_gain, ln2_bias):
    for l in range(DEPTH):
        lambda_init = 0.8 - 0.6 * math.exp(-0.3 * l)
        mix = mixer_sublayer(x, positions, w_in[l], ret_gn_gain[l], diff_lambda_q1[l], diff_lambda_k1[l],
                             diff_lambda_q2[l], diff_lambda_k2[l], diff_subln_gain[l], w_ret_proj[l],
                             w_diff_proj[l], w_out[l], lambda_init)
        h = layer_norm(DEEPNORM_ALPHA * x + mix, ln1_gain[l], ln1_bias[l])
        ffn = hierarchical_moe(h, w_group[l], b_group[l], w_router[l], b_router[l],
                               w_expert_gate[l], w_expert_up[l], w_expert_down[l])
        x = layer_norm(DEEPNORM_ALPHA * h + ffn, ln2_gain[l], ln2_bias[l])
    return x
```

```cpp
#include <hip/hip_runtime.h>
#include <cstdio>
#include <cstdint>

#define DI __device__ __forceinline__
#define LAS __attribute__((address_space(3)))
typedef unsigned short bf16_t;
typedef short bf16x8 __attribute__((ext_vector_type(8)));
typedef float f32x4 __attribute__((ext_vector_type(4)));
typedef float f32x16 __attribute__((ext_vector_type(16)));
typedef unsigned u32x4 __attribute__((ext_vector_type(4)));
typedef unsigned u32x2 __attribute__((ext_vector_type(2)));
#define MFMA32(a, b, c) __builtin_amdgcn_mfma_f32_32x32x16_bf16((a), (b), (c), 0, 0, 0)

constexpr int NTOK = 16384, SEQ = 4096, DM = 2048, NIN = 16384, NEXP = 32, FF = 1024;
constexpr float ALPHA = 1.189207115002721f;
constexpr float LN_EPS = 1e-5f;
constexpr float QK_SCALE = 0.08838834764831845f;
constexpr float LOG2E = 1.4426950408889634f;
constexpr float LAMBDA_INIT = 0.2f;

constexpr size_t MiB = 1ull << 20;
constexpr size_t WS_CTL = 0;
constexpr size_t WS_TAB = 2 * MiB;
constexpr size_t WS_ROUTE = 12 * MiB;
constexpr size_t WS_WR = 20 * MiB, WS_WD = 28 * MiB, WS_WO = 36 * MiB;
constexpr size_t WS_WGU = 44 * MiB;
constexpr size_t WS_WDN = 300 * MiB;
constexpr size_t WS_XB = 428 * MiB, WS_WIN = 492 * MiB;
constexpr size_t WS_RQ = 556 * MiB, WS_RK = 588 * MiB, WS_RV = 620 * MiB, WS_RG = 684 * MiB, WS_DQ = 748 * MiB, WS_DK = 812 * MiB, WS_DV = 876 * MiB, WS_GATES = 940 * MiB;
constexpr size_t WS_END = 1068 * MiB;
constexpr size_t WS_O0 = WS_XB, WS_O1 = WS_WIN;
constexpr size_t WS_ACT = WS_XB;
constexpr size_t WS_DIFFA = WS_WIN;
constexpr size_t WS_TMP = WS_RQ;
constexpr size_t WS_MERGED = WS_RV;
constexpr size_t WS_HB = WS_DV;
constexpr bool GATES_FP8 = true;
constexpr size_t WS_XB8 = 172 * MiB, WS_WIN8 = 204 * MiB;
constexpr bool PROJ_FP8 = true;
constexpr size_t WS_RETA8 = WS_XB8, WS_DIFFA8 = WS_WIN8;
constexpr size_t WS_HB8 = WS_DQ;
constexpr size_t WS_YKC = WS_RQ;
constexpr size_t WS_YK = WS_GATES;
constexpr size_t TAB_COSR = WS_TAB, TAB_SINR = WS_TAB + 4 * MiB, TAB_COSD = WS_TAB + 8 * MiB, TAB_SIND = WS_TAB + 9 * MiB, TAB_MISC = WS_TAB + 10 * MiB;
constexpr size_t CW_K2 = WS_CTL + 65536 + 1024;
constexpr size_t RT_TOKE = WS_ROUTE, RT_TOKW = WS_ROUTE + 128 * 1024, RT_CNT = WS_CTL + 65536  , RT_SLOTTOK = WS_ROUTE + 1 * MiB, RT_SLOTW = WS_ROUTE + 3 * MiB,
                 RT_SLOTDST = WS_ROUTE + 5 * MiB, RT_WRT = WS_ROUTE + 7 * MiB  ;

struct Params {
    const float* x; const int* pos; const float* w_in; const float* ret_gn; const float* lq1; const float* lk1; const float* lq2; const float* lk2; const float* subln;
    const float* w_ret_proj; const float* w_diff_proj; const float* w_out; const float* ln1g; const float* ln1b; const float* w_group; const float* b_group;
    const float* w_router; const float* b_router; const float* w_gate; const float* w_up; const float* w_down; const float* ln2g; const float* ln2b;
    float* out; unsigned char* ws;
};

constexpr bool FAST_ATTN = true, MIX256 = true;
DI unsigned f2bf(float f) { unsigned u = __float_as_uint(f); return (u + 0x7fffu + ((u >> 16) & 1u)) >> 16; }
DI float bf2f(unsigned b) { return __uint_as_float(b << 16); }
DI unsigned pk4_fp8(float a, float b, float c, float d) {
    a = fminf(fmaxf(a, -448.f), 448.f); b = fminf(fmaxf(b, -448.f), 448.f); c = fminf(fmaxf(c, -448.f), 448.f); d = fminf(fmaxf(d, -448.f), 448.f);
    int w = __builtin_amdgcn_cvt_pk_fp8_f32(a, b, 0, false); w = __builtin_amdgcn_cvt_pk_fp8_f32(c, d, w, true); return (unsigned)w; }
constexpr float F8_SX = 4.f, F8_SW = 64.f, F8_SACT = 8.f;
DI unsigned pk2(float lo, float hi) { unsigned r; asm volatile("v_cvt_pk_bf16_f32 %0, %1, %2" : "=v"(r) : "v"(lo), "v"(hi)); return r; }
DI int crow(int reg, int h) { return (reg & 3) + 8 * (reg >> 2) + 4 * h; }
DI float wave_sum(float v) {
#pragma unroll
    for (int o = 1; o < 64; o <<= 1) v += __shfl_xor(v, o);
    return v;
}
DI float sigmoidf_(float v) { return 1.f / (1.f + __expf(-v)); }
DI void unpack8(const u32x4 w, float (&f)[8]) { f[0] = bf2f(w.x & 0xffff); f[1] = bf2f(w.x >> 16); f[2] = bf2f(w.y & 0xffff); f[3] = bf2f(w.y >> 16); f[4] = bf2f(w.z & 0xffff); f[5] = bf2f(w.z >> 16); f[6] = bf2f(w.w & 0xffff); f[7] = bf2f(w.w >> 16); }
DI int inproj_dst_row(int c) {
    if (c < 2048) { const int w = c & 127, base = c - w, s = w >> 6, i = w & 63; return base + 2 * i + s; }
    if (c >= 6144 && c < 10240) { const int w = c & 127, base = c - w; if (w < 32) { const int s = w >> 4, i = w & 15; return base + 2 * i + s; } return c; }
    return c;
}
struct SegInfo { bf16_t* base; int ld; int cl; int rope; float scale; };
DI SegInfo seg_of(unsigned char* ws, int n) {
    SegInfo s; s.rope = 0; s.scale = 1.f;
    if (n < 1024) { s.base = (bf16_t*)(ws + WS_RQ); s.ld = 2048; s.cl = n; s.rope = 1; }
    else if (n < 2048) { s.base = (bf16_t*)(ws + WS_RQ); s.ld = 2048; s.cl = n; s.rope = 1; s.scale = QK_SCALE; }
    else if (n < 4096) { s.base = (bf16_t*)(ws + WS_RV); s.ld = 2048; s.cl = n - 2048; }
    else if (n < 6144) { s.base = (bf16_t*)(ws + WS_RG); s.ld = 2048; s.cl = n - 4096; }
    else if (n < 8192) { s.base = (bf16_t*)(ws + WS_DQ); s.ld = 2048; s.cl = n - 6144; s.rope = 2; }
    else if (n < 10240) { s.base = (bf16_t*)(ws + WS_DK); s.ld = 2048; s.cl = n - 8192; s.rope = 2; }
    else if (n < 12288) { s.base = (bf16_t*)(ws + WS_DV); s.ld = 2048; s.cl = n - 10240; }
    else { s.base = (bf16_t*)(ws + WS_GATES); s.ld = 4096; s.cl = n - 12288; }
    return s;
}

#ifndef PREP_TK
#define PREP_TK 64
#endif
constexpr int TK = PREP_TK, TN = 8192 / TK;
struct TItem { const float* src; bf16_t* dst; int ld, ldd, k0, n0, mode, f8; };
DI int titem_row(const TItem& t, int n) { return t.mode == 0 ? n : (t.mode == 1 ? inproj_dst_row(n) : (t.mode == 4 ? n : (n >> 7) * 256 + (n & 127) + (t.mode - 2) * 128)); }
constexpr int I_IN = (DM / TK) * (NIN / TN), I_SQ = (DM / TK) * (DM / TN), I_E = (DM / TK) * (FF / TN)  , I_D = (FF / TK) * (DM / TN);
constexpr int PREP_ITEMS = I_IN + 3 * I_SQ + NEXP * (2 * I_E + I_D);
DI TItem titem_decode(const Params& p, int it) {
    unsigned char* ws = p.ws; TItem t; int r = it;
    if (r < I_IN) { t.src = p.w_in; t.ld = NIN; t.dst = (bf16_t*)(ws + WS_WIN); t.ldd = DM; t.k0 = (r / (NIN / TN)) * TK; t.n0 = (r % (NIN / TN)) * TN; t.mode = 1; t.f8 = 0;
        if (GATES_FP8 && (t.n0 >= 10240 || (t.n0 >= 2048 && t.n0 < 6144))) { t.dst = (bf16_t*)(ws + WS_WIN8); t.mode = 4; t.f8 = 1; } return t; } r -= I_IN;
    if (r < 3 * I_SQ) { const int m = r / I_SQ, q = r % I_SQ; t.src = m == 0 ? p.w_ret_proj : (m == 1 ? p.w_diff_proj : p.w_out); t.dst = (bf16_t*)(ws + (m == 0 ? WS_WR : (m == 1 ? WS_WD : WS_WO)));
        t.ld = DM; t.ldd = DM; t.k0 = (q / (DM / TN)) * TK; t.n0 = (q % (DM / TN)) * TN; t.mode = 0; t.f8 = (PROJ_FP8 && m < 2) ? 1 : 0; return t; } r -= 3 * I_SQ;
    const int e = r / (2 * I_E + I_D); int q = r % (2 * I_E + I_D);
    if (q < 2 * I_E) { const int up = q / I_E; q %= I_E; t.src = (up ? p.w_up : p.w_gate) + (size_t)e * DM * FF; t.dst = (bf16_t*)(ws + WS_WGU + (size_t)e * 2048 * DM); t.ld = FF; t.ldd = DM; t.k0 = (q / (FF / TN)) * TK; t.n0 = (q % (FF / TN)) * TN; t.mode = 2 + up; t.f8 = 1; return t; }
    q -= 2 * I_E;
    t.src = p.w_down + (size_t)e * FF * DM; t.dst = (bf16_t*)(ws + WS_WDN + (size_t)e * DM * FF); t.ld = DM; t.ldd = FF; t.k0 = (q / (DM / TN)) * TK; t.n0 = (q % (DM / TN)) * TN; t.mode = 0; t.f8 = 1; return t;
}
DI void titem_load(const TItem& t, f32x4 (&r)[4]) {
    const int tid = threadIdx.x, k = tid / (TN / 4), n4 = tid % (TN / 4);
#pragma unroll
    for (int i = 0; i < 4; ++i) r[i] = __builtin_nontemporal_load((const f32x4*)(t.src + (size_t)(t.k0 + k + (TK / 4) * i) * t.ld + t.n0 + 4 * n4));
}
DI void prep_range(const Params& p, LAS unsigned char* lds, int first, int step, int n) {
    LAS float* tile = (LAS float*)lds;
    const int tid = threadIdx.x;
    if (n <= 0) return;
    { int it = first, left = n - 1; TItem cur = titem_decode(p, it); f32x4 r[4]; titem_load(cur, r);
      for (;;) {
        const int nx = it + step; const bool has = left > 0; TItem nt = cur; f32x4 r2[4];
        if (has) { nt = titem_decode(p, nx); titem_load(nt, r2); }
        { const int k = tid / (TN / 4), n4 = tid % (TN / 4);
#pragma unroll
          for (int i = 0; i < 4; ++i)
#pragma unroll
              for (int j = 0; j < 4; ++j) tile[(k + (TK / 4) * i) * (TN + 1) + 4 * n4 + j] = r[i][j]; }
        __syncthreads();
        { const int n_ = tid / (TK / 16), part = tid % (TK / 16);
          if (cur.f8) { unsigned w[4];
#pragma unroll
              for (int j = 0; j < 4; ++j) w[j] = pk4_fp8(tile[(part * 16 + 4 * j) * (TN + 1) + n_] * F8_SW, tile[(part * 16 + 4 * j + 1) * (TN + 1) + n_] * F8_SW, tile[(part * 16 + 4 * j + 2) * (TN + 1) + n_] * F8_SW, tile[(part * 16 + 4 * j + 3) * (TN + 1) + n_] * F8_SW);
              *(u32x4*)((unsigned char*)cur.dst + (size_t)titem_row(cur, cur.n0 + n_) * cur.ldd + cur.k0 + part * 16) = (u32x4){w[0], w[1], w[2], w[3]}; }
          else { unsigned w[8];
#pragma unroll
              for (int j = 0; j < 8; ++j) w[j] = pk2(tile[(part * 16 + 2 * j) * (TN + 1) + n_], tile[(part * 16 + 2 * j + 1) * (TN + 1) + n_]);
              bf16_t* d = cur.dst + (size_t)titem_row(cur, cur.n0 + n_) * cur.ldd + cur.k0 + part * 16;
              *(u32x4*)d = (u32x4){w[0], w[1], w[2], w[3]}; *(u32x4*)(d + 8) = (u32x4){w[4], w[5], w[6], w[7]}; } }
        __syncthreads();
        if (!has) break;
        cur = nt; it = nx; --left;
#pragma unroll
        for (int i = 0; i < 4; ++i) r[i] = r2[i];
      } }
}
constexpr int FILL_RS = 10, FILL_RS_ITEMS = FILL_RS * 128, FILL_SK_ITEMS = 32 * 3 * 28, FILL_ITEMS = FILL_RS_ITEMS + FILL_SK_ITEMS;
DI void prep_fill_rs(const Params& p, LAS unsigned char* lds) {
    if (gridDim.x != 256 || blockIdx.x < 128) return;
    prep_range(p, lds, PREP_ITEMS - FILL_ITEMS + ((int)blockIdx.x - 128), 128, FILL_RS);
}
DI void prep_fill_skew(const Params& p, LAS unsigned char* lds) {
    const int g = (blockIdx.x >> 3) & 7, j = (blockIdx.x & 7) + 8 * (blockIdx.x >> 6);
    prep_range(p, lds, PREP_ITEMS - FILL_SK_ITEMS + 48 * g * (g - 1) + j, 32, 3 * g);
}
DI void phase_prep(const Params& p, LAS unsigned char* lds) {
    unsigned char* ws = p.ws;
    const int tid = threadIdx.x, G = gridDim.x, bid = blockIdx.x;
    { const int n0 = (G == 256) ? PREP_ITEMS - FILL_ITEMS : PREP_ITEMS; constexpr int NW0 = I_IN + 3 * I_SQ;
      prep_range(p, lds, NW0 + bid, G, (n0 - NW0 - bid + G - 1) / G);
      prep_range(p, lds, bid, G, (NW0 - bid + G - 1) / G); }
    { const size_t n8 = (size_t)NTOK * DM / 8; bf16_t* xb = (bf16_t*)(ws + WS_XB);
      for (size_t i = (size_t)bid * 512 + tid; i < n8; i += (size_t)G * 512) { const f32x4 a = __builtin_nontemporal_load((const f32x4*)(p.x + i * 8)), b = __builtin_nontemporal_load((const f32x4*)(p.x + i * 8 + 4));
          *(u32x4*)(xb + i * 8) = (u32x4){pk2(a[0], a[1]), pk2(a[2], a[3]), pk2(b[0], b[1]), pk2(b[2], b[3])};
          if (GATES_FP8) *(u32x2*)(ws + WS_XB8 + i * 8) = (u32x2){pk4_fp8(a[0] * F8_SX, a[1] * F8_SX, a[2] * F8_SX, a[3] * F8_SX), pk4_fp8(b[0] * F8_SX, b[1] * F8_SX, b[2] * F8_SX, b[3] * F8_SX)}; } }
    { float* cosR = (float*)(ws + TAB_COSR); float* sinR = (float*)(ws + TAB_SINR); float* cosD = (float*)(ws + TAB_COSD); float* sinD = (float*)(ws + TAB_SIND);
      LAS float* invf = (LAS float*)lds;
      __syncthreads();
      if (tid < 64) invf[tid] = (float)(1.0 / pow(10000.0, (double)(2 * tid) / 128.0)); else if (tid < 80) invf[tid] = (float)(1.0 / pow(500000.0, (double)(2 * (tid - 64)) / 32.0));
      __syncthreads();
      for (int i = bid * 512 + tid; i < NTOK * 80; i += G * 512) { const int t = i / 80, f = i % 80; const float ang = (float)p.pos[t] * invf[f];
          const double a = (double)ang, k = rint(a * 0.15915494309189535); const float r = (float)((a - k * 6.283185307179586) - k * 2.4492935982947064e-16);
          const float s = sinf(r), c = cosf(r);
          if (f < 64) { cosR[t * 64 + f] = c; sinR[t * 64 + f] = s; } else { cosD[t * 16 + f - 64] = c; sinD[t * 16 + f - 64] = s; } } }
    { float* wrt = (float*)(ws + RT_WRT);
      for (int i = bid * 512 + tid; i < 36 * DM; i += G * 512) { const int e = i / DM, k = i % DM; wrt[i] = e < 4 ? p.w_group[k * 4 + e] : p.w_router[k * 32 + (e - 4)]; }
      if (bid == 0 && tid < 36) wrt[36 * DM + tid] = tid < 4 ? p.b_group[tid] : p.b_router[tid - 4]; }
    if (bid == 0 && tid < 64) { float a = 0.f, b = 0.f; for (int i = tid; i < 128; i += 64) { a += p.lq1[i] * p.lk1[i]; b += p.lq2[i] * p.lk2[i]; }
        a = wave_sum(a); b = wave_sum(b); if (tid == 0) ((float*)(ws + TAB_MISC))[0] = expf(a) - expf(b) + LAMBDA_INIT; }
}

template <class AF, class BF>
DI void sgemm64(f32x16 (&acc)[2][2], AF arow, BF brow, int K, int lane) {
    const int r = lane & 31, h = lane >> 5;
    const bf16_t* pa0 = arow(r) + 8 * h; const bf16_t* pa1 = arow(32 + r) + 8 * h;
    const bf16_t* pb0 = brow(r) + 8 * h; const bf16_t* pb1 = brow(32 + r) + 8 * h;
#pragma unroll
    for (int i = 0; i < 2; ++i)
#pragma unroll
        for (int j = 0; j < 2; ++j)
#pragma unroll
            for (int q = 0; q < 16; ++q) acc[i][j][q] = 0.f;
#pragma unroll 4
    for (int k0 = 0; k0 < K; k0 += 16) {
        const bf16x8 a0 = *(const bf16x8*)(pa0 + k0), a1 = *(const bf16x8*)(pa1 + k0), b0 = *(const bf16x8*)(pb0 + k0), b1 = *(const bf16x8*)(pb1 + k0);
        acc[0][0] = MFMA32(a0, b0, acc[0][0]); acc[0][1] = MFMA32(a0, b1, acc[0][1]); acc[1][0] = MFMA32(a1, b0, acc[1][0]); acc[1][1] = MFMA32(a1, b1, acc[1][1]);
    }
}

DI void inproj_store_elem(const Params& p, int t, int n, float v, float pv) {
    const SegInfo s = seg_of(p.ws, n); const int w = s.cl & 127; float o = v;
    if (s.rope == 1) { const int i = w >> 1; const float c = ((const float*)(p.ws + TAB_COSR))[t * 64 + i], sn = ((const float*)(p.ws + TAB_SINR))[t * 64 + i]; o = (w & 1) ? v * c + pv * sn : v * c - pv * sn; }
    else if (s.rope == 2 && w < 32) { const int i = w >> 1; const float c = ((const float*)(p.ws + TAB_COSD))[t * 16 + i], sn = ((const float*)(p.ws + TAB_SIND))[t * 16 + i]; o = (w & 1) ? v * c + pv * sn : v * c - pv * sn; }
    s.base[(size_t)t * s.ld + s.cl] = (bf16_t)f2bf(o * s.scale);
}
DI void n_inproj(const Params& p) {
    const int lane = threadIdx.x & 63, gw = blockIdx.x * 8 + (threadIdx.x >> 6), NW = gridDim.x * 8, r = lane & 31, h = lane >> 5;
    const bf16_t* xb = (const bf16_t*)(p.ws + WS_XB); const bf16_t* wt = (const bf16_t*)(p.ws + WS_WIN);
    for (int T = gw; T < 256 * 256; T += NW) { const int tm = T / 256, tn = T % 256; f32x16 acc[2][2];
        sgemm64(acc, [&](int i) { return xb + (size_t)(tm * 64 + i) * DM; }, [&](int j) { return wt + (size_t)(tn * 64 + j) * DM; }, DM, lane);
#pragma unroll
        for (int mi = 0; mi < 2; ++mi)
#pragma unroll
            for (int ni = 0; ni < 2; ++ni)
#pragma unroll
                for (int q = 0; q < 16; ++q) { const float v = acc[mi][ni][q], pv = __shfl_xor(v, 1); inproj_store_elem(p, tm * 64 + mi * 32 + crow(q, h), tn * 64 + ni * 32 + r, v, pv); }
    }
}

template <int MODE>
DI void naive_attn_wave(const bf16_t* Q, const bf16_t* Kp, int ldqk, const bf16_t* V, bf16_t* O, int q0, float lg2gamma, LAS bf16_t* vl, int lane) {
    const int r = lane & 31, h = lane >> 5;
    bf16x8 qf[8];
#pragma unroll
    for (int ks = 0; ks < 8; ++ks) qf[ks] = *(const bf16x8*)(Q + (size_t)(q0 + r) * ldqk + ks * 16 + 8 * h);
    const int kend = ((q0 >> 6) + 1) << 6;
    constexpr float C2 = QK_SCALE * LOG2E;
    float m = -1e30f, l = 0.f, rl = 1.f;
    if (MODE == 1) {
        for (int kt = 0; kt < kend; kt += 32) {
            f32x16 st = {};
#pragma unroll
            for (int ks = 0; ks < 8; ++ks) { const bf16x8 kf = *(const bf16x8*)(Kp + (size_t)(kt + r) * ldqk + ks * 16 + 8 * h); st = MFMA32(kf, qf[ks], st); }
            float tm = st[0];
#pragma unroll
            for (int q = 1; q < 16; ++q) tm = fmaxf(tm, st[q]);
            tm = fmaxf(tm, __shfl_xor(tm, 32));
            const float mn = fmaxf(m, tm); float ps = 0.f;
#pragma unroll
            for (int q = 0; q < 16; ++q) ps += exp2f((st[q] - mn) * C2);
            ps += __shfl_xor(ps, 32);
            l = l * exp2f((m - mn) * C2) + ps; m = mn;
        }
        rl = 1.f / l;
    }
    f32x16 o[8];
#pragma unroll
    for (int cb = 0; cb < 8; ++cb)
#pragma unroll
        for (int q = 0; q < 16; ++q) o[cb][q] = 0.f;
    for (int kt = 0; kt < kend; kt += 32) {
        f32x16 st = {};
#pragma unroll
        for (int ks = 0; ks < 8; ++ks) { const bf16x8 kf = *(const bf16x8*)(Kp + (size_t)(kt + r) * ldqk + ks * 16 + 8 * h); st = MFMA32(kf, qf[ks], st); }
        float pr[16];
#pragma unroll
        for (int q = 0; q < 16; ++q) {
            if (MODE == 0) { const int d = (q0 + r) - (kt + crow(q, h)); pr[q] = st[q] * exp2f(lg2gamma * (float)(d < 0 ? -d : d)); }
            else pr[q] = exp2f((st[q] - m) * C2) * rl;
        }
        bf16x8 pa[2];
#pragma unroll
        for (int s = 0; s < 2; ++s) { u32x4 w = {pk2(pr[8 * s], pr[8 * s + 1]), pk2(pr[8 * s + 2], pr[8 * s + 3]), pk2(pr[8 * s + 4], pr[8 * s + 5]), pk2(pr[8 * s + 6], pr[8 * s + 7])}; pa[s] = __builtin_bit_cast(bf16x8, w); }
        asm volatile("s_waitcnt lgkmcnt(0)" ::: "memory");
#pragma unroll
        for (int i = 0; i < 16; ++i) { const int idx = i * 64 + lane, row = idx >> 5, ch = idx & 31; const u32x4 v = *(const u32x4*)(V + (size_t)(kt + row) * 2048 + ch * 8); *(LAS u32x4*)(vl + row * 256 + ch * 8) = v; }
        asm volatile("s_waitcnt vmcnt(0) lgkmcnt(0)" ::: "memory");
#pragma unroll
        for (int s = 0; s < 2; ++s)
#pragma unroll
            for (int cb = 0; cb < 8; ++cb) { bf16x8 vb;
#pragma unroll
                for (int j = 0; j < 8; ++j) vb[j] = (short)vl[crow(8 * s + j, h) * 256 + cb * 32 + r];
                o[cb] = MFMA32(pa[s], vb, o[cb]); }
    }
#pragma unroll
    for (int cb = 0; cb < 8; ++cb)
#pragma unroll
        for (int q = 0; q < 16; ++q) O[(size_t)(q0 + crow(q, h)) * 2048 + cb * 32 + r] = (bf16_t)f2bf(o[cb][q]);
}
DI void n_mixers(const Params& p, LAS unsigned char* lds) {
    const int lane = threadIdx.x & 63, wid = threadIdx.x >> 6, gw = blockIdx.x * 8 + wid, NW = gridDim.x * 8;
    LAS bf16_t* vl = (LAS bf16_t*)(lds + wid * 16384);
    unsigned char* ws = p.ws;
    for (int U = gw, it = 0; U < 4 * 8 * 128; U += NW, ++it) { int qb = U & 127; if (it & 1) qb = 127 - qb; const int bh = U >> 7, b = bh >> 3, h = bh & 7;
        const float gam = 1.f - exp2f(-5.f - (float)h); const float lg = log2f(gam);
        naive_attn_wave<0>((const bf16_t*)(ws + WS_RQ) + (size_t)b * SEQ * 2048 + h * 128, (const bf16_t*)(ws + WS_RQ) + (size_t)b * SEQ * 2048 + 1024 + h * 128, 2048,
                           (const bf16_t*)(ws + WS_RV) + (size_t)b * SEQ * 2048 + h * 256, (bf16_t*)p.out + (size_t)b * SEQ * 2048 + h * 256, qb * 32, lg, vl, lane); }
    for (int U = gw, it = 0; U < 4 * 8 * 2 * 128; U += NW, ++it) { int qb = U & 127; if (it & 1) qb = 127 - qb; const int bhi = U >> 7, i = bhi & 1, h = (bhi >> 1) & 7, b = bhi >> 4;
        naive_attn_wave<1>((const bf16_t*)(ws + WS_DQ) + (size_t)b * SEQ * 2048 + h * 256 + i * 128, (const bf16_t*)(ws + WS_DK) + (size_t)b * SEQ * 2048 + h * 256 + i * 128, 2048,
                           (const bf16_t*)(ws + WS_DV) + (size_t)b * SEQ * 2048 + h * 256, (bf16_t*)(ws + (i ? WS_O1 : WS_O0)) + (size_t)b * SEQ * 2048 + h * 256, qb * 32, 0.f, vl, lane); }
}

DI float half_sum(float v) {
#pragma unroll
    for (int o = 1; o < 32; o <<= 1) v += __shfl_xor(v, o);
    return v;
}
DI void phase_norms(const Params& p) {
    const int lane = threadIdx.x & 63, gw = blockIdx.x * 8 + (threadIdx.x >> 6), NW = gridDim.x * 8;
    unsigned char* ws = p.ws; const float lam = ((const float*)(ws + TAB_MISC))[0];
    const bf16_t* rr = (const bf16_t*)p.out; const bf16_t* rg = (const bf16_t*)(ws + WS_RG); const bf16_t* o0 = (const bf16_t*)(ws + WS_O0); const bf16_t* o1 = (const bf16_t*)(ws + WS_O1);
    bf16_t* retA = (bf16_t*)p.out; bf16_t* diffA = (bf16_t*)(ws + WS_DIFFA);
    const int e0 = (lane & 31) * 8;
    f32x4 sgl = *(const f32x4*)(p.subln + e0), sgh = *(const f32x4*)(p.subln + e0 + 4);
    for (int t = gw; t < NTOK; t += NW) {
        u32x4 wr_[4], wg_[4], wa_[4], wb_[4];
#pragma unroll
        for (int j = 0; j < 4; ++j) { const size_t off = (size_t)t * DM + j * 512 + lane * 8; wr_[j] = *(const u32x4*)(rr + off); wg_[j] = *(const u32x4*)(rg + off); wa_[j] = *(const u32x4*)(o0 + off); wb_[j] = *(const u32x4*)(o1 + off); }
#pragma unroll
        for (int j = 0; j < 4; ++j) { const size_t off = (size_t)t * DM + j * 512 + lane * 8; const int c = j * 512 + lane * 8;
            float v[8], g[8], a[8], bb[8], y[8];
            unpack8(wr_[j], v); unpack8(wg_[j], g); unpack8(wa_[j], a); unpack8(wb_[j], bb);
            float s = 0.f;
#pragma unroll
            for (int k = 0; k < 8; ++k) s += v[k];
            const float mean = half_sum(s) * (1.f / 256.f); float q = 0.f;
#pragma unroll
            for (int k = 0; k < 8; ++k) { v[k] -= mean; q += v[k] * v[k]; }
            const float rstd = rsqrtf(half_sum(q) * (1.f / 256.f) + LN_EPS);
            const f32x4 gl = *(const f32x4*)(p.ret_gn + c), gh = *(const f32x4*)(p.ret_gn + c + 4);
#pragma unroll
            for (int k = 0; k < 8; ++k) y[k] = v[k] * rstd * (k < 4 ? gl[k & 3] : gh[k & 3]) * (g[k] * sigmoidf_(g[k]));
            *(u32x4*)(retA + off) = (u32x4){pk2(y[0], y[1]), pk2(y[2], y[3]), pk2(y[4], y[5]), pk2(y[6], y[7])};
            float d[8], ms = 0.f;
#pragma unroll
            for (int k = 0; k < 8; ++k) { d[k] = a[k] - lam * bb[k]; ms += d[k] * d[k]; }
            const float rs = rsqrtf(half_sum(ms) * (1.f / 256.f) + LN_EPS) * (1.f - LAMBDA_INIT);
#pragma unroll
            for (int k = 0; k < 8; ++k) y[k] = d[k] * rs * (k < 4 ? sgl[k & 3] : sgh[k & 3]);
            *(u32x4*)(diffA + off) = (u32x4){pk2(y[0], y[1]), pk2(y[2], y[3]), pk2(y[4], y[5]), pk2(y[6], y[7])}; }
    }
}

DI void n_proj(const Params& p) {
    const int lane = threadIdx.x & 63, gw = blockIdx.x * 8 + (threadIdx.x >> 6), NW = gridDim.x * 8, r = lane & 31, h = lane >> 5;
    unsigned char* ws = p.ws; const bf16_t* gates = (const bf16_t*)(ws + WS_GATES); bf16_t* merged = (bf16_t*)(ws + WS_MERGED);
    for (int T = gw; T < 256 * 32; T += NW) { const int tm = T / 32, tn = T % 32; f32x16 a1[2][2], a2[2][2];
        sgemm64(a1, [&](int i) { return (const bf16_t*)p.out + (size_t)(tm * 64 + i) * DM; }, [&](int j) { return (const bf16_t*)(ws + WS_WR) + (size_t)(tn * 64 + j) * DM; }, DM, lane);
        sgemm64(a2, [&](int i) { return (const bf16_t*)(ws + WS_DIFFA) + (size_t)(tm * 64 + i) * DM; }, [&](int j) { return (const bf16_t*)(ws + WS_WD) + (size_t)(tn * 64 + j) * DM; }, DM, lane);
#pragma unroll
        for (int mi = 0; mi < 2; ++mi)
#pragma unroll
            for (int ni = 0; ni < 2; ++ni)
#pragma unroll
                for (int q = 0; q < 16; ++q) { const int t = tm * 64 + mi * 32 + crow(q, h), c = tn * 64 + ni * 32 + r;
                    const float gr = bf2f(gates[(size_t)t * 4096 + c]), gd = bf2f(gates[(size_t)t * 4096 + 2048 + c]);
                    const float t1 = bf2f(f2bf(sigmoidf_(gr) * a1[mi][ni][q]));
                    merged[(size_t)t * DM + c] = (bf16_t)f2bf(t1 + sigmoidf_(gd) * a2[mi][ni][q]); }
    }
}
DI void n_outproj(const Params& p) {
    const int lane = threadIdx.x & 63, gw = blockIdx.x * 8 + (threadIdx.x >> 6), NW = gridDim.x * 8, r = lane & 31, h = lane >> 5;
    unsigned char* ws = p.ws;
    for (int T = gw; T < 256 * 32; T += NW) { const int tm = T / 32, tn = T % 32; f32x16 a[2][2];
        sgemm64(a, [&](int i) { return (const bf16_t*)(ws + WS_MERGED) + (size_t)(tm * 64 + i) * DM; }, [&](int j) { return (const bf16_t*)(ws + WS_WO) + (size_t)(tn * 64 + j) * DM; }, DM, lane);
#pragma unroll
        for (int mi = 0; mi < 2; ++mi)
#pragma unroll
            for (int ni = 0; ni < 2; ++ni)
#pragma unroll
                for (int q = 0; q < 16; ++q) { const size_t o = (size_t)(tm * 64 + mi * 32 + crow(q, h)) * DM + tn * 64 + ni * 32 + r; p.out[o] = ALPHA * p.x[o] + a[mi][ni][q]; }
    }
}

DI void phase_ln1_router(const Params& p) {
    const int lane = threadIdx.x & 63, gw = blockIdx.x * 8 + (threadIdx.x >> 6), NW = gridDim.x * 8;
    unsigned char* ws = p.ws; bf16_t* hb = (bf16_t*)(ws + WS_HB); const float* wrt = (const float*)(ws + RT_WRT);
    int* cnt = (int*)(ws + RT_CNT); int* stok = (int*)(ws + RT_SLOTTOK); float* sw = (float*)(ws + RT_SLOTW); int* sdst = (int*)(ws + RT_SLOTDST);
    for (int t0 = gw * 4; t0 < NTOK; t0 += NW * 4) {
        f32x4 v[4][8];
#pragma unroll
        for (int q = 0; q < 4; ++q) { const float* row = p.x + (size_t)(t0 + q) * DM; const bf16_t* mrow = (const bf16_t*)p.out + (size_t)(t0 + q) * DM; float s = 0.f;
#pragma unroll
            for (int j = 0; j < 8; ++j) { const f32x4 xv = __builtin_nontemporal_load((const f32x4*)(row + j * 256 + lane * 4)); const u32x2 mw = __builtin_nontemporal_load((const u32x2*)(mrow + j * 256 + lane * 4));
                v[q][j] = xv * ALPHA + (f32x4){bf2f(mw.x & 0xffff), bf2f(mw.x >> 16), bf2f(mw.y & 0xffff), bf2f(mw.y >> 16)}; s += (v[q][j][0] + v[q][j][1]) + (v[q][j][2] + v[q][j][3]); }
            const float mean = wave_sum(s) * (1.f / DM); float qq = 0.f;
#pragma unroll
            for (int j = 0; j < 8; ++j) { v[q][j] = v[q][j] - mean; qq += (v[q][j][0] * v[q][j][0] + v[q][j][1] * v[q][j][1]) + (v[q][j][2] * v[q][j][2] + v[q][j][3] * v[q][j][3]); }
            const float rstd = rsqrtf(wave_sum(qq) * (1.f / DM) + LN_EPS);
#pragma unroll
            for (int j = 0; j < 8; ++j) { const f32x4 g = *(const f32x4*)(p.ln1g + j * 256 + lane * 4), bb = *(const f32x4*)(p.ln1b + j * 256 + lane * 4);
                v[q][j] = v[q][j] * rstd * g + bb;
                *(u32x2*)(hb + (size_t)(t0 + q) * DM + j * 256 + lane * 4) = (u32x2){pk2(v[q][j][0], v[q][j][1]), pk2(v[q][j][2], v[q][j][3])};
                *(unsigned*)(ws + WS_HB8 + (size_t)(t0 + q) * DM + j * 256 + lane * 4) = pk4_fp8(v[q][j][0] * F8_SX, v[q][j][1] * F8_SX, v[q][j][2] * F8_SX, v[q][j][3] * F8_SX); } }
        float logit[4] = {0.f, 0.f, 0.f, 0.f};
        for (int e = 0; e < 36; ++e) { f32x4 w[8]; float a[4] = {0.f, 0.f, 0.f, 0.f};
#pragma unroll
            for (int j = 0; j < 8; ++j) w[j] = *(const f32x4*)(wrt + (size_t)e * DM + j * 256 + lane * 4);
#pragma unroll
            for (int q = 0; q < 4; ++q) {
#pragma unroll
                for (int j = 0; j < 8; ++j) a[q] += (v[q][j][0] * w[j][0] + v[q][j][1] * w[j][1]) + (v[q][j][2] * w[j][2] + v[q][j][3] * w[j][3]);
                a[q] = wave_sum(a[q]) + wrt[36 * DM + e]; if (lane == e) logit[q] = a[q]; } }
#pragma unroll
        for (int q = 0; q < 4; ++q) { const float mylogit = logit[q]; const int t = t0 + q;
            float gl[4];
#pragma unroll
            for (int g = 0; g < 4; ++g) gl[g] = __shfl(mylogit, g);
            int gs = 0; float gm = gl[0];
#pragma unroll
            for (int g = 1; g < 4; ++g) if (gl[g] > gm) { gm = gl[g]; gs = g; }
            float den = 0.f;
#pragma unroll
            for (int g = 0; g < 4; ++g) den += __expf(gl[g] - gm);
            const float pg = 1.f / den;
            float wv[8];
#pragma unroll
            for (int i = 0; i < 8; ++i) wv[i] = __shfl(mylogit, 4 + gs * 8 + i);
            int i1 = 0; float v1 = wv[0];
#pragma unroll
            for (int i = 1; i < 8; ++i) if (wv[i] > v1) { v1 = wv[i]; i1 = i; }
            int i2 = -1; float v2 = -3.0e38f;
#pragma unroll
            for (int i = 0; i < 8; ++i) if (i != i1 && wv[i] > v2) { v2 = wv[i]; i2 = i; }
            const float e2 = __expf(v2 - v1), w1 = pg / (1.f + e2), w2 = pg * e2 / (1.f + e2);
            if (lane < 2) { const int e = gs * 8 + (lane ? i2 : i1); const int pos = atomicAdd(cnt + e, 1);
                stok[e * NTOK + pos] = t; ((int*)(ws + RT_TOKE))[t * 2 + lane] = e * NTOK + pos; ((float*)(ws + RT_TOKW))[t * 2 + lane] = lane ? w2 : w1; } }
    }
}
DI void phase_slots(const Params& p, LAS unsigned char* lds) {
    unsigned char* ws = p.ws; const int* tok_e = (const int*)(ws + RT_TOKE); const float* tok_w = (const float*)(ws + RT_TOKW);
    LAS int* wsum = (LAS int*)lds;
    const int tid = threadIdx.x, lane = tid & 63, wid = tid >> 6;
    for (int e = blockIdx.x; e < NEXP; e += gridDim.x) {
        int* st = (int*)(ws + RT_SLOTTOK) + e * NTOK; float* sw = (float*)(ws + RT_SLOTW) + e * NTOK; int* sd = (int*)(ws + RT_SLOTDST) + e * NTOK;
        int base = 0;
        for (int it = 0; it < (2 * NTOK) / 512; ++it) { const int a = it * 512 + tid; const bool f = tok_e[a] == e;
            const unsigned long long bal = __ballot(f); const int pre = __popcll(bal & ((1ull << lane) - 1ull)), tot = __popcll(bal);
            if (lane == 0) wsum[wid] = tot;
            __syncthreads();
            int woff = 0, all = 0;
#pragma unroll
            for (int w = 0; w < 8; ++w) { const int c = wsum[w]; if (w < wid) woff += c; all += c; }
            if (f) { const int pos = base + woff + pre; st[pos] = a >> 1; sw[pos] = tok_w[a]; sd[pos] = a; }
            base += all;
            __syncthreads(); }
        if (tid == 0) ((int*)(ws + RT_CNT))[e] = base;
    }
}
DI void n_moe_up(const Params& p) {
    const int lane = threadIdx.x & 63, gw = blockIdx.x * 8 + (threadIdx.x >> 6), NW = gridDim.x * 8, r = lane & 31, h = lane >> 5;
    unsigned char* ws = p.ws; const int* cnt = (const int*)(ws + RT_CNT); const bf16_t* hb = (const bf16_t*)(ws + WS_HB); bf16_t* act = (bf16_t*)(ws + WS_ACT);
    int idx = gw, base = 0;
    for (int e = 0; e < NEXP; ++e) { const int c = cnt[e], mt = (c + 63) >> 6, ne = mt * 32; const int* st = (const int*)(ws + RT_SLOTTOK) + e * NTOK;
        const bf16_t* W = (const bf16_t*)(ws + WS_WGU) + (size_t)e * 2048 * DM;
        while (idx < ne) { const int m = idx >> 5, f = idx & 31; f32x16 a[2][2];
            sgemm64(a, [&](int i) { int s = m * 64 + i; if (s > c - 1) s = c - 1; return hb + (size_t)st[s] * DM; },
                       [&](int j) { const int ff = f * 32 + (j & 31); return W + (size_t)((ff >> 7) * 256 + (ff & 127) + (j >= 32 ? 128 : 0)) * DM; }, DM, lane);
#pragma unroll
            for (int mi = 0; mi < 2; ++mi)
#pragma unroll
                for (int q = 0; q < 16; ++q) { const int s = m * 64 + mi * 32 + crow(q, h); if (s < c) { const float g = a[mi][0][q], u = a[mi][1][q]; act[(size_t)(base + s) * FF + f * 32 + r] = (bf16_t)f2bf(g * sigmoidf_(g) * u); } }
            idx += NW; }
        idx -= ne; base += (c + 255) & ~255; }
}
DI void n_moe_down(const Params& p) {
    const int lane = threadIdx.x & 63, gw = blockIdx.x * 8 + (threadIdx.x >> 6), NW = gridDim.x * 8, r = lane & 31, h = lane >> 5;
    unsigned char* ws = p.ws; const int* cnt = (const int*)(ws + RT_CNT); const bf16_t* act = (const bf16_t*)(ws + WS_ACT); bf16_t* yk = (bf16_t*)(ws + WS_YK);
    int idx = gw, base = 0;
    for (int e = 0; e < NEXP; ++e) { const int c = cnt[e], mt = (c + 63) >> 6, ne = mt * 32; const int* sd = (const int*)(ws + RT_SLOTDST) + e * NTOK; const float* sw = (const float*)(ws + RT_SLOTW) + e * NTOK;
        const bf16_t* W = (const bf16_t*)(ws + WS_WDN) + (size_t)e * DM * FF;
        while (idx < ne) { const int m = idx >> 5, cn = idx & 31; f32x16 a[2][2];
            sgemm64(a, [&](int i) { int s = m * 64 + i; if (s > c - 1) s = c - 1; return act + (size_t)(base + s) * FF; }, [&](int j) { return W + (size_t)(cn * 64 + j) * FF; }, FF, lane);
#pragma unroll
            for (int mi = 0; mi < 2; ++mi)
#pragma unroll
                for (int q = 0; q < 16; ++q) { const int s = m * 64 + mi * 32 + crow(q, h); if (s < c) { const int d = sd[s]; const float w = sw[s];
#pragma unroll
                    for (int ni = 0; ni < 2; ++ni) yk[(size_t)(d & 1) * NTOK * DM + (size_t)(d >> 1) * DM + cn * 64 + ni * 32 + r] = (bf16_t)f2bf(w * a[mi][ni][q]); } }
            idx += NW; }
        idx -= ne; base += (c + 255) & ~255; }
}
DI void phase_final(const Params& p) {
    const int lane = threadIdx.x & 63, gw = blockIdx.x * 8 + (threadIdx.x >> 6), NW = gridDim.x * 8;
    const bf16_t* ykc = (const bf16_t*)(p.ws + WS_YKC); const bf16_t* hbp = (const bf16_t*)(p.ws + WS_HB);
    const int* tslot = (const int*)(p.ws + RT_TOKE); const float* tw = (const float*)(p.ws + RT_TOKW); const int* cnt = (const int*)(p.ws + RT_CNT);
    int mybase = 0; { const int e = lane & 31; for (int q = 0; q < e; ++q) mybase += (cnt[q] + 255) & ~255; }
    for (int t = gw; t < NTOK; t += NW) {
        const int s0 = tslot[t * 2], s1 = tslot[t * 2 + 1]; const float w0 = tw[t * 2], w1 = tw[t * 2 + 1];
        const size_t r0 = (size_t)(__shfl(mybase, s0 >> 14) + (s0 & (NTOK - 1))), r1 = (size_t)(__shfl(mybase, s1 >> 14) + (s1 & (NTOK - 1)));
        float* row = p.out + (size_t)t * DM; float v[4][8]; float s = 0.f;
        u32x4 hw[4], aw[4], bw[4];
#pragma unroll
        for (int j = 0; j < 4; ++j) { const size_t c = j * 512 + lane * 8; hw[j] = __builtin_nontemporal_load((const u32x4*)(hbp + (size_t)t * DM + c)); aw[j] = __builtin_nontemporal_load((const u32x4*)(ykc + r0 * DM + c)); bw[j] = __builtin_nontemporal_load((const u32x4*)(ykc + r1 * DM + c)); }
#pragma unroll
        for (int j = 0; j < 4; ++j) { float hv[8], a[8], b[8]; unpack8(hw[j], hv); unpack8(aw[j], a); unpack8(bw[j], b);
#pragma unroll
            for (int k = 0; k < 8; ++k) { v[j][k] = ALPHA * hv[k] + (w0 * a[k] + w1 * b[k]); s += v[j][k]; } }
        const float mean = wave_sum(s) * (1.f / DM); float q = 0.f;
#pragma unroll
        for (int j = 0; j < 4; ++j)
#pragma unroll
            for (int k = 0; k < 8; ++k) { v[j][k] -= mean; q += v[j][k] * v[j][k]; }
        const float rstd = rsqrtf(wave_sum(q) * (1.f / DM) + LN_EPS);
#pragma unroll
        for (int j = 0; j < 4; ++j) { const int c = j * 512 + lane * 8; const f32x4 g0 = *(const f32x4*)(p.ln2g + c), g1 = *(const f32x4*)(p.ln2g + c + 4), b0 = *(const f32x4*)(p.ln2b + c), b1 = *(const f32x4*)(p.ln2b + c + 4);
            *(f32x4*)(row + c) = (f32x4){v[j][0] * rstd * g0[0] + b0[0], v[j][1] * rstd * g0[1] + b0[1], v[j][2] * rstd * g0[2] + b0[2], v[j][3] * rstd * g0[3] + b0[3]};
            *(f32x4*)(row + c + 4) = (f32x4){v[j][4] * rstd * g1[0] + b1[0], v[j][5] * rstd * g1[1] + b1[1], v[j][6] * rstd * g1[2] + b1[2], v[j][7] * rstd * g1[3] + b1[3]}; }
    }
}

namespace pg8 {
constexpr int BM = 256, BK = 64, HALF = 128, HTB = HALF * BK * 2  , STAGE_BYTES = 8 * HTB, NXCD = 8, WGM = 8;
DI int lds_byte(int r, int c) { const int st = (r >> 4) * 2 + (c >> 5), rr = r & 15, cc = c & 31, ob = rr * 64 + cc * 2; return st * 1024 + (ob ^ (((ob >> 9) & 1) << 5)); }
DI void stage_rc(int b, int& R, int& C) { const int st = b / 1024, sb = b % 1024, swz = sb ^ (((sb >> 9) & 1) << 5); R = (st >> 1) * 16 + swz / 64; C = (st & 1) * 32 + (swz % 64) / 2; }
DI int perm32(int rho) { const int n = rho >> 4, i = rho & 15; return 8 * (i >> 2) + 4 * n + (i & 3); }

struct Unit { const char* A; const char* B; int pm, pn, e, rows, rowbase, slot0; };

struct StaticOrder {
    static constexpr bool GATHER = false;
    const char* A; const char* Bt; int K; int nM, nN, nwg, G, c; int split = 1 << 30, off0 = 0, off1 = 0;
    DI void init(const bf16_t* A_, const bf16_t* Bt_, int M, int N, int K_, int G_, int c_) { A = (const char*)A_; Bt = (const char*)Bt_; K = K_; nM = M / BM; nN = N / BM; nwg = nM * nN; G = G_; c = c_; }
    DI bool next(int i, Unit& u) const {
        const long L = (long)i * G + c; if (L >= nwg) return false;
        int wgid = (int)L; { const int q = nwg / NXCD, r = nwg % NXCD, xcd = wgid % NXCD, off = wgid / NXCD; wgid = (xcd < r ? xcd * (q + 1) : r * (q + 1) + (xcd - r) * q) + off; }
        const int nig = WGM * nN, gid = wgid / nig, fm = gid * WGM, gsz = (nM - fm) < WGM ? (nM - fm) : WGM;
        u.pm = fm + ((wgid % nig) % gsz); u.pn = (wgid % nig) / gsz; u.pn += u.pn < split ? off0 : off1;
        u.A = A + (size_t)u.pm * BM * K * 2; u.B = Bt + (size_t)u.pn * BM * K * 2; u.e = 0; u.rows = BM; u.rowbase = u.pm * BM; u.slot0 = 0; return true;
    }
    DI unsigned goff(const Unit&, int, unsigned) const { return 0u; }
};

DI unsigned cvt_pk_bf16(float lo, float hi) { unsigned r; asm volatile("v_cvt_pk_bf16_f32 %0, %1, %2" : "=v"(r) : "v"(lo), "v"(hi)); return r; }

template <class Epi, class Sched, bool ALIGN_EPI = false, bool SP2 = false>
DI void gemm_phase(LAS unsigned char* lds, const int K, const Sched& S, const Epi& E) {
    constexpr bool GATHER = Sched::GATHER;
    int tid_ = threadIdx.x; asm volatile("" : "+v"(tid_));
    const int tid = tid_, wid = __builtin_amdgcn_readfirstlane(tid >> 6), lane = tid & 63, wr = wid >> 2, wc = wid & 3, fr = lane & 15, fq = lane >> 4;
    const int nt = K / BK;
    unsigned voffA[2], voffB[2]; unsigned gpk[2];
#pragma unroll
    for (int i = 0; i < 2; ++i) { int R, C; stage_rc(tid * 16 + i * 8192, R, C); const int Rb = Epi::PERM ? ((R & ~31) + perm32(R & 31)) : R;
        voffA[i] = (unsigned)(R * K + C) * 2u; voffB[i] = (unsigned)(Rb * K + C) * 2u; gpk[i] = ((unsigned)R << 8) | (unsigned)C; }
    const size_t kstep = (size_t)(BK * 2);
    const size_t hstep = (size_t)HALF * K * 2;
    const unsigned ldsw = (unsigned)wid * 1024u;
    const int aoff = lds_byte(wr * 64 + fr, fq * 8), boff = lds_byte(wc * 32 + fr, fq * 8);
#define PG8_SA(b, h) (((b) * 2 + (h)) * HTB)
#define PG8_SB(b, h) ((4 + (b) * 2 + (h)) * HTB)
#define PG8_STAGE(bufoff, gbase, voff) do { _Pragma("unroll") for (int _i = 0; _i < 2; ++_i) \
        __builtin_amdgcn_global_load_lds((const unsigned*)((const char*)(gbase) + (voff)[_i]), (LAS unsigned*)(lds + (bufoff) + ldsw + _i * 8192), 16, 0, 0); } while (0)
#define PG8_STAGE_A(bufoff, NX, hh, kb) do { if constexpr (GATHER) { _Pragma("unroll") for (int _i = 0; _i < 2; ++_i) \
        __builtin_amdgcn_global_load_lds((const unsigned*)(gA + S.goff((NX) ? nxt : cur, hh, gpk[_i]) + (kb)), (LAS unsigned*)(lds + (bufoff) + ldsw + _i * 8192), 16, 0, 0); } \
        else { PG8_STAGE(bufoff, ((NX) ? nA : cA) + (hh) * hstep + (kb), voffA); } } while (0)
    typedef int i32x4_ __attribute__((ext_vector_type(4))); typedef int i32x8_ __attribute__((ext_vector_type(8)));
#define PG8_LDA(dst, b, h) do { _Pragma("unroll") for (int m = 0; m < 4; ++m) { if constexpr (Epi::FP8) dst##8[m] = __builtin_shufflevector(*(const LAS i32x4_*)(lds + PG8_SA(b, h) + aoff + m * 2048), *(const LAS i32x4_*)(lds + PG8_SA(b, h) + aoff + m * 2048 + 1024), 0, 1, 2, 3, 4, 5, 6, 7); \
        else { _Pragma("unroll") for (int k = 0; k < 2; ++k) dst[m][k] = *(const LAS bf16x8*)(lds + PG8_SA(b, h) + aoff + m * 2048 + k * 1024); } } } while (0)
#define PG8_LDB(dst, b, h) do { _Pragma("unroll") for (int n = 0; n < 2; ++n) { if constexpr (Epi::FP8) dst##8[n] = __builtin_shufflevector(*(const LAS i32x4_*)(lds + PG8_SB(b, h) + boff + n * 2048), *(const LAS i32x4_*)(lds + PG8_SB(b, h) + boff + n * 2048 + 1024), 0, 1, 2, 3, 4, 5, 6, 7); \
        else { _Pragma("unroll") for (int k = 0; k < 2; ++k) dst[n][k] = *(const LAS bf16x8*)(lds + PG8_SB(b, h) + boff + n * 2048 + k * 1024); } } } while (0)
#define PG8_MMA(ai, bj, At, Bt) do { __builtin_amdgcn_s_setprio(1); _Pragma("unroll") for (int m = 0; m < 4; ++m) _Pragma("unroll") for (int n = 0; n < 2; ++n) { \
        if constexpr (Epi::FP8) { asm volatile("v_mfma_scale_f32_16x16x128_f8f6f4 %0, %1, %2, %0, %3, %4 op_sel_hi:[0,0,0]" : "+v"(acc[ai][bj][m][n]) : "v"(Bt##8[n]), "v"(At##8[m]), "v"(f8sw), "v"(f8sx)); } \
        else { _Pragma("unroll") for (int k = 0; k < 2; ++k) acc[ai][bj][m][n] = __builtin_amdgcn_mfma_f32_16x16x32_bf16(Bt[n][k], At[m][k], acc[ai][bj][m][n], 0, 0, 0); } } \
        __builtin_amdgcn_s_setprio(0); } while (0)
#define PG8_WAIT_V(n) asm volatile("s_waitcnt vmcnt(" #n ")" ::: "memory")
#define PG8_WAIT_L(n) asm volatile("s_waitcnt lgkmcnt(" #n ")" ::: "memory")
#define PG8_BAR __builtin_amdgcn_s_barrier()
#define PG8_SCHED __builtin_amdgcn_sched_barrier(0)
    Unit cur, nxt; int ui = 0;
    if (!S.next(0, cur)) return;
    f32x4 acc[2][2][4][2];
#pragma unroll
    for (int a = 0; a < 2; ++a)
#pragma unroll
        for (int b = 0; b < 2; ++b)
#pragma unroll
            for (int m = 0; m < 4; ++m)
#pragma unroll
                for (int n = 0; n < 2; ++n) acc[a][b][m][n] = (f32x4){0.f, 0.f, 0.f, 0.f};
    bf16x8 At[4][2], B0[2][2], B1[2][2]; i32x8_ At8[4], B08[2], B18[2];
    int f8sw = Epi::SCALE_W, f8sx = Epi::SCALE_X; asm volatile("" : "+v"(f8sw), "+v"(f8sx));
    const char* cA = cur.A; const char* cB = cur.B; const char* nA = cA; const char* nB = cB;
    const char* gA = nullptr;
    if constexpr (GATHER) { gA = S.gbase; }
    if constexpr (SP2) {
        PG8_STAGE(PG8_SB(0, 0), cB, voffB); PG8_STAGE(PG8_SB(0, 1), cB + hstep, voffB); PG8_STAGE_A(PG8_SA(0, 0), false, 0, 0); PG8_STAGE_A(PG8_SA(0, 1), false, 1, 0);
        if (wr == 1) PG8_BAR;
        PG8_WAIT_V(2); PG8_BAR;
        PG8_STAGE(PG8_SB(1, 0), cB + kstep, voffB); PG8_STAGE_A(PG8_SA(1, 0), false, 0, kstep); PG8_STAGE(PG8_SB(1, 1), cB + hstep + kstep, voffB);
        PG8_WAIT_V(6); PG8_BAR;
    } else {
        PG8_STAGE(PG8_SB(0, 0), cB, voffB); PG8_STAGE_A(PG8_SA(0, 0), false, 0, 0); PG8_STAGE(PG8_SB(0, 1), cB + hstep, voffB); PG8_STAGE_A(PG8_SA(0, 1), false, 1, 0);
        if (wr == 1) PG8_BAR;
        PG8_WAIT_V(4); PG8_BAR;
        PG8_STAGE(PG8_SB(1, 0), cB + kstep, voffB); PG8_STAGE_A(PG8_SA(1, 0), false, 0, kstep); PG8_STAGE(PG8_SB(1, 1), cB + hstep + kstep, voffB);
        PG8_WAIT_V(6); PG8_BAR;
    }
    for (;;) {
        const bool has_next = S.next(ui + 1, nxt);
        nA = has_next ? nxt.A : cA; nB = has_next ? nxt.B : cB;
        if (!has_next) nxt = cur;
#pragma unroll 1
        for (int t = 0; t < nt; t += 2) {
            const bool last = (t == nt - 2);
            const size_t k1 = (size_t)(t + 1) * kstep;
            const size_t k2 = last ? 0 : (size_t)(t + 2) * kstep, k3 = k2 + kstep;
            const char* b2 = last ? nB : cB + k2; const char* b3 = b2 + kstep;
            if constexpr (SP2) {
            PG8_LDB(B0, 0, 0); PG8_LDB(B1, 0, 1); PG8_SCHED; PG8_LDA(At, 0, 0); PG8_STAGE_A(PG8_SA(1, 1), false, 1, k1);
            PG8_WAIT_V(8); PG8_WAIT_L(0); PG8_BAR; PG8_MMA(0, 0, At, B0); PG8_MMA(0, 1, At, B1); PG8_BAR; PG8_SCHED;
            PG8_LDA(At, 0, 1); PG8_STAGE(PG8_SB(0, 0), b2, voffB); PG8_STAGE(PG8_SB(0, 1), b2 + hstep, voffB); if (last) PG8_STAGE_A(PG8_SA(0, 0), true, 0, k2); else PG8_STAGE_A(PG8_SA(0, 0), false, 0, k2);
            PG8_WAIT_V(8); PG8_WAIT_L(0); PG8_BAR; PG8_MMA(1, 0, At, B0); PG8_MMA(1, 1, At, B1); PG8_BAR; PG8_SCHED;
            PG8_LDB(B0, 1, 0); PG8_LDB(B1, 1, 1); PG8_SCHED; PG8_LDA(At, 1, 0); if (last) PG8_STAGE_A(PG8_SA(0, 1), true, 1, k2); else PG8_STAGE_A(PG8_SA(0, 1), false, 1, k2);
            PG8_WAIT_V(8); PG8_WAIT_L(0); PG8_BAR; PG8_MMA(0, 0, At, B0); PG8_MMA(0, 1, At, B1); PG8_BAR; PG8_SCHED;
            PG8_LDA(At, 1, 1); PG8_STAGE(PG8_SB(1, 0), b3, voffB); PG8_STAGE(PG8_SB(1, 1), b3 + hstep, voffB); if (last) PG8_STAGE_A(PG8_SA(1, 0), true, 0, k3); else PG8_STAGE_A(PG8_SA(1, 0), false, 0, k3);
            PG8_WAIT_V(8); PG8_WAIT_L(0); PG8_BAR; PG8_MMA(1, 0, At, B0); PG8_MMA(1, 1, At, B1); PG8_BAR; PG8_SCHED;
            } else {
            PG8_LDB(B0, 0, 0); PG8_SCHED; PG8_LDA(At, 0, 0); PG8_STAGE_A(PG8_SA(1, 1), false, 1, k1);
            PG8_WAIT_L(8); PG8_BAR; PG8_WAIT_L(0); PG8_MMA(0, 0, At, B0); PG8_BAR; PG8_SCHED;
            PG8_LDB(B1, 0, 1); PG8_STAGE(PG8_SB(0, 0), b2, voffB);
            PG8_BAR; PG8_WAIT_L(0); PG8_MMA(0, 1, At, B1); PG8_BAR;
            PG8_LDA(At, 0, 1); if (last) PG8_STAGE_A(PG8_SA(0, 0), true, 0, k2); else PG8_STAGE_A(PG8_SA(0, 0), false, 0, k2);
            PG8_BAR; PG8_WAIT_L(0); PG8_MMA(1, 0, At, B0); PG8_BAR; PG8_SCHED;
            PG8_STAGE(PG8_SB(0, 1), b2 + hstep, voffB);
            PG8_WAIT_V(6); PG8_BAR; PG8_MMA(1, 1, At, B1); PG8_BAR;
            PG8_LDB(B0, 1, 0); PG8_SCHED; PG8_LDA(At, 1, 0); if (last) PG8_STAGE_A(PG8_SA(0, 1), true, 1, k2); else PG8_STAGE_A(PG8_SA(0, 1), false, 1, k2);
            PG8_WAIT_L(8); PG8_BAR; PG8_WAIT_L(0); PG8_MMA(0, 0, At, B0); PG8_BAR; PG8_SCHED;
            PG8_LDB(B1, 1, 1); PG8_STAGE(PG8_SB(1, 0), b3, voffB);
            PG8_BAR; PG8_WAIT_L(0); PG8_MMA(0, 1, At, B1); PG8_BAR;
            PG8_LDA(At, 1, 1); if (last) PG8_STAGE_A(PG8_SA(1, 0), true, 0, k3); else PG8_STAGE_A(PG8_SA(1, 0), false, 0, k3);
            PG8_BAR; PG8_WAIT_L(0); PG8_MMA(1, 0, At, B0); PG8_BAR; PG8_SCHED;
            PG8_STAGE(PG8_SB(1, 1), b3 + hstep, voffB);
            PG8_WAIT_V(6); PG8_BAR; PG8_MMA(1, 1, At, B1); PG8_BAR;
            }
        }
        if constexpr (ALIGN_EPI) { if (wr == 0) PG8_BAR; }
        if constexpr (Epi::FP8) asm volatile("s_nop 15\n\ts_nop 15" ::: "memory");
        if constexpr (Epi::PAIRED) { if (cur.e == 0) E.mid(acc, cur, wr, wc, fr, fq); else E(acc, cur, wr, wc, fr, fq); } else E(acc, cur, wr, wc, fr, fq);
        if (!has_next) break;
        if (!(Epi::PAIRED && cur.e == 0)) {
#pragma unroll
        for (int a = 0; a < 2; ++a)
#pragma unroll
            for (int b = 0; b < 2; ++b)
#pragma unroll
                for (int m = 0; m < 4; ++m)
#pragma unroll
                    for (int n = 0; n < 2; ++n) acc[a][b][m][n] = (f32x4){0.f, 0.f, 0.f, 0.f}; }
        cur = nxt; cA = nA; cB = nB; ++ui;
        if constexpr (ALIGN_EPI) { if (wr == 1) PG8_BAR; }
    }
    PG8_WAIT_V(0);
    if constexpr (!ALIGN_EPI) { if (wr == 0) PG8_BAR; }
    PG8_BAR;
#undef PG8_SA
#undef PG8_SB
#undef PG8_STAGE
#undef PG8_STAGE_A
#undef PG8_LDA
#undef PG8_LDB
#undef PG8_MMA
#undef PG8_WAIT_V
#undef PG8_WAIT_L
#undef PG8_BAR
#undef PG8_SCHED
}
}

template <bool F8> struct EpiInProjT {
    static constexpr bool PERM = true, FP8 = F8; static constexpr bool PAIRED = false; static constexpr int SCALE_W = 0x79797979, SCALE_X = 0x7d7d7d7d;
    unsigned char* ws;
    DI void operator()(const f32x4 (&acc)[2][2][4][2], const pg8::Unit& u, int wr, int wc, int fr, int fq) const {
        const SegInfo s = seg_of(ws, u.pn * 256);
        const int row0 = u.pm * 256 + wr * 64 + fr, cl0 = s.cl + wc * 32 + 8 * fq;
        const float* ct = nullptr; const float* st = nullptr; int tl = 0, ti = 0;
        if (s.rope == 1) { ct = (const float*)(ws + TAB_COSR); st = (const float*)(ws + TAB_SINR); tl = 64; ti = 16 * wc + 4 * fq; }
        else if (s.rope == 2 && wc == 0) { ct = (const float*)(ws + TAB_COSD); st = (const float*)(ws + TAB_SIND); tl = 16; ti = 4 * fq; }
        const float sc = s.scale;
        const bool kn = !F8 && s.rope == 2 && u.pn >= 32;
        float kmx[2] = {0.f, 0.f};
        if (ct) {
#pragma unroll
            for (int ai = 0; ai < 2; ++ai) {
                f32x4 c4[4], s4[4];
#pragma unroll
                for (int m = 0; m < 4; ++m) { const size_t t = row0 + ai * 128 + m * 16; c4[m] = *(const f32x4*)(ct + t * tl + ti); s4[m] = *(const f32x4*)(st + t * tl + ti); }
#pragma unroll
                for (int m = 0; m < 4; ++m) { bf16_t* rowp = s.base + (size_t)(row0 + ai * 128 + m * 16) * s.ld + cl0; const f32x4 cc = c4[m] * sc, ss = s4[m] * sc;
#pragma unroll
                    for (int bj = 0; bj < 2; ++bj) { const f32x4 v0 = acc[ai][bj][m][0], v1 = acc[ai][bj][m][1];
                        const float o0 = v0[0] * cc[0] - v0[1] * ss[0], o1 = v0[1] * cc[0] + v0[0] * ss[0], o2 = v0[2] * cc[1] - v0[3] * ss[1], o3 = v0[3] * cc[1] + v0[2] * ss[1];
                        const float o4 = v1[0] * cc[2] - v1[1] * ss[2], o5 = v1[1] * cc[2] + v1[0] * ss[2], o6 = v1[2] * cc[3] - v1[3] * ss[3], o7 = v1[3] * cc[3] + v1[2] * ss[3];
                        *(u32x4*)(rowp + bj * 128) = (u32x4){pg8::cvt_pk_bf16(o0, o1), pg8::cvt_pk_bf16(o2, o3), pg8::cvt_pk_bf16(o4, o5), pg8::cvt_pk_bf16(o6, o7)};
                        if (kn) { float q_ = (o0 * o0 + o1 * o1) + (o2 * o2 + o3 * o3) + (o4 * o4 + o5 * o5) + (o6 * o6 + o7 * o7); q_ += __shfl_xor(q_, 16); q_ += __shfl_xor(q_, 32); kmx[bj] = fmaxf(kmx[bj], q_); } } } }
        } else {
#pragma unroll
            for (int g = 0; g < 8; ++g) { const int ai = g >> 2, m = g & 3; bf16_t* rowp = s.base + (size_t)(row0 + ai * 128 + m * 16) * s.ld + cl0;
#pragma unroll
                for (int bj = 0; bj < 2; ++bj) { const f32x4 v0 = acc[ai][bj][m][0] * sc, v1 = acc[ai][bj][m][1] * sc;
                    *(u32x4*)(rowp + bj * 128) = (u32x4){pg8::cvt_pk_bf16(v0[0], v0[1]), pg8::cvt_pk_bf16(v0[2], v0[3]), pg8::cvt_pk_bf16(v1[0], v1[1]), pg8::cvt_pk_bf16(v1[2], v1[3])};
                    if (kn) { float q_ = (v0[0] * v0[0] + v0[1] * v0[1]) + (v0[2] * v0[2] + v0[3] * v0[3]) + (v1[0] * v1[0] + v1[1] * v1[1]) + (v1[2] * v1[2] + v1[3] * v1[3]); q_ += __shfl_xor(q_, 16); q_ += __shfl_xor(q_, 32); kmx[bj] = fmaxf(kmx[bj], q_); } } }
        }
        if (kn) {
#pragma unroll
            for (int bj = 0; bj < 2; ++bj) { float q_ = kmx[bj];
#pragma unroll
                for (int o_ = 1; o_ < 16; o_ <<= 1) q_ = fmaxf(q_, __shfl_xor(q_, o_));
                if (fr == 0 && fq == 0) atomicMax((unsigned*)(ws + CW_K2) + (((u.pm >> 4) * 8 + (u.pn - 32)) * 2 + bj) * 4 + wc, __float_as_uint(q_)); } }
    }
};
template <int STEP, bool F8 = false> struct EpiProj {
    static constexpr bool PERM = true, FP8 = F8; static constexpr bool PAIRED = false; static constexpr int SCALE_W = 0x79797979, SCALE_X = 0x7d7d7d7d;
    const bf16_t* gates; const bf16_t* tmp_in; bf16_t* out;
    DI void operator()(const f32x4 (&acc)[2][2][4][2], const pg8::Unit& u, int wr, int wc, int fr, int fq) const {
        const int row0 = u.pm * 256 + wr * 64 + fr, col0 = u.pn * 256 + wc * 32 + 8 * fq;
#pragma unroll
        for (int ai = 0; ai < 2; ++ai) {
            u32x4 gw[4][2], tw[4][2];
#pragma unroll
            for (int m = 0; m < 4; ++m)
#pragma unroll
                for (int bj = 0; bj < 2; ++bj) { const size_t t = row0 + ai * 128 + m * 16; const int c = col0 + bj * 128; gw[m][bj] = *(const u32x4*)(gates + t * 4096 + STEP * 2048 + c);
                    if (STEP == 1) tw[m][bj] = *(const u32x4*)(tmp_in + t * DM + c); else tw[m][bj] = (u32x4){0u, 0u, 0u, 0u}; }
#pragma unroll
            for (int m = 0; m < 4; ++m)
#pragma unroll
                for (int bj = 0; bj < 2; ++bj) { const size_t t = row0 + ai * 128 + m * 16; const int c = col0 + bj * 128; float g[8], tp[8], o[8];
                    unpack8(gw[m][bj], g); unpack8(tw[m][bj], tp);
                    const f32x4 v0 = acc[ai][bj][m][0], v1 = acc[ai][bj][m][1];
#pragma unroll
                    for (int j = 0; j < 8; ++j) { const float a = j < 4 ? v0[j & 3] : v1[j & 3]; o[j] = sigmoidf_(g[j]) * a + (STEP == 1 ? tp[j] : 0.f); }
                    *(u32x4*)(out + t * DM + c) = (u32x4){pg8::cvt_pk_bf16(o[0], o[1]), pg8::cvt_pk_bf16(o[2], o[3]), pg8::cvt_pk_bf16(o[4], o[5]), pg8::cvt_pk_bf16(o[6], o[7])}; } }
    }
};
struct EpiOut {
    static constexpr bool PERM = false, FP8 = false; static constexpr bool PAIRED = false; static constexpr int SCALE_W = 0, SCALE_X = 0;
    const float* x; float* y;
    DI void operator()(const f32x4 (&acc)[2][2][4][2], const pg8::Unit& u, int wr, int wc, int fr, int fq) const {
        const int row0 = u.pm * 256 + wr * 64 + fr, col0 = u.pn * 256 + wc * 32 + 4 * fq;
#pragma unroll
        for (int ai = 0; ai < 2; ++ai) {
            f32x4 xv[4][2][2];
#pragma unroll
            for (int m = 0; m < 4; ++m) { const size_t o = (size_t)(row0 + ai * 128 + m * 16) * DM + col0;
#pragma unroll
                for (int bj = 0; bj < 2; ++bj)
#pragma unroll
                    for (int n = 0; n < 2; ++n) xv[m][bj][n] = *(const f32x4*)(x + o + bj * 128 + n * 16); }
#pragma unroll
            for (int m = 0; m < 4; ++m) { const size_t o = (size_t)(row0 + ai * 128 + m * 16) * DM + col0;
#pragma unroll
                for (int bj = 0; bj < 2; ++bj)
#pragma unroll
                    for (int n = 0; n < 2; ++n) *(f32x4*)(y + o + bj * 128 + n * 16) = xv[m][bj][n] * ALPHA + acc[ai][bj][m][n]; } }
    }
};
struct EpiMix {
    static constexpr bool PERM = true, FP8 = false; static constexpr bool PAIRED = false; static constexpr int SCALE_W = 0, SCALE_X = 0;
    bf16_t* y;
    DI void operator()(const f32x4 (&acc)[2][2][4][2], const pg8::Unit& u, int wr, int wc, int fr, int fq) const {
        const int row0 = u.pm * 256 + wr * 64 + fr, col0 = u.pn * 256 + wc * 32 + 8 * fq;
#pragma unroll
        for (int ai = 0; ai < 2; ++ai)
#pragma unroll
            for (int m = 0; m < 4; ++m) { bf16_t* rowp = y + (size_t)(row0 + ai * 128 + m * 16) * DM + col0;
#pragma unroll
                for (int bj = 0; bj < 2; ++bj) { const f32x4 v0 = acc[ai][bj][m][0], v1 = acc[ai][bj][m][1];
                    *(u32x4*)(rowp + bj * 128) = (u32x4){pg8::cvt_pk_bf16(v0[0], v0[1]), pg8::cvt_pk_bf16(v0[2], v0[3]), pg8::cvt_pk_bf16(v1[0], v1[1]), pg8::cvt_pk_bf16(v1[2], v1[3])}; } }
    }
};
struct PairOrder {
    static constexpr bool GATHER = false;
    pg8::StaticOrder S0; const char* A0; const char* A1; const char* B0; const char* B1;
    DI bool next(int i, pg8::Unit& u) const {
        if (!S0.next(i >> 1, u)) return false;
        const int step = i & 1; u.A = (step ? A1 : A0) + (size_t)u.pm * pg8::BM * S0.K * 2; u.B = (step ? B1 : B0) + (size_t)u.pn * pg8::BM * S0.K * 2; u.e = step; return true;
    }
    DI unsigned goff(const pg8::Unit&, int, unsigned) const { return 0u; }
};
struct EpiProjPair {
    static constexpr bool PERM = true, FP8 = true, PAIRED = true; static constexpr int SCALE_W = 0x79797979, SCALE_X = 0x7d7d7d7d;
    const bf16_t* gates; bf16_t* out;
    DI void mid(f32x4 (&acc)[2][2][4][2], const pg8::Unit& u, int wr, int wc, int fr, int fq) const {
        const int row0 = u.pm * 256 + wr * 64 + fr, col0 = u.pn * 256 + wc * 32 + 8 * fq;
#pragma unroll
        for (int ai = 0; ai < 2; ++ai) {
            u32x4 gr[4][2], gd[4][2];
#pragma unroll
            for (int m = 0; m < 4; ++m)
#pragma unroll
                for (int bj = 0; bj < 2; ++bj) { const size_t t = row0 + ai * 128 + m * 16; const int c = col0 + bj * 128; gr[m][bj] = *(const u32x4*)(gates + t * 4096 + c); gd[m][bj] = *(const u32x4*)(gates + t * 4096 + 2048 + c); }
#pragma unroll
            for (int m = 0; m < 4; ++m)
#pragma unroll
                for (int bj = 0; bj < 2; ++bj) { float a[8], d[8]; unpack8(gr[m][bj], a); unpack8(gd[m][bj], d);
#pragma unroll
                    for (int j = 0; j < 8; ++j) { const float r = (1.f + __expf(-d[j])) * __builtin_amdgcn_rcpf(1.f + __expf(-a[j])); acc[ai][bj][m][j >> 2][j & 3] *= r; } } }
    }
    DI void operator()(const f32x4 (&acc)[2][2][4][2], const pg8::Unit& u, int wr, int wc, int fr, int fq) const {
        const int row0 = u.pm * 256 + wr * 64 + fr, col0 = u.pn * 256 + wc * 32 + 8 * fq;
#pragma unroll
        for (int ai = 0; ai < 2; ++ai) {
            u32x4 gd[4][2];
#pragma unroll
            for (int m = 0; m < 4; ++m)
#pragma unroll
                for (int bj = 0; bj < 2; ++bj) { const size_t t = row0 + ai * 128 + m * 16; const int c = col0 + bj * 128; gd[m][bj] = *(const u32x4*)(gates + t * 4096 + 2048 + c); }
#pragma unroll
            for (int m = 0; m < 4; ++m)
#pragma unroll
                for (int bj = 0; bj < 2; ++bj) { const size_t t = row0 + ai * 128 + m * 16; const int c = col0 + bj * 128; float d[8], o[8]; unpack8(gd[m][bj], d);
                    const f32x4 v0 = acc[ai][bj][m][0], v1 = acc[ai][bj][m][1];
#pragma unroll
                    for (int j = 0; j < 8; ++j) o[j] = sigmoidf_(d[j]) * (j < 4 ? v0[j & 3] : v1[j & 3]);
                    *(u32x4*)(out + t * DM + c) = (u32x4){pg8::cvt_pk_bf16(o[0], o[1]), pg8::cvt_pk_bf16(o[2], o[3]), pg8::cvt_pk_bf16(o[4], o[5]), pg8::cvt_pk_bf16(o[6], o[7])}; } }
    }
};
DI void stagger8(int step_sleeps) {
    const int n = ((blockIdx.x >> 3) & 7) * step_sleeps;
    for (int k = 0; k < n; ++k) __builtin_amdgcn_s_sleep(127);
}
DI void f_inproj(const Params& p, LAS unsigned char* lds) {
    if (gridDim.x == 256) prep_fill_skew(p, lds); else stagger8(2);
    if constexpr (GATES_FP8) {
        { pg8::StaticOrder S; S.init((const bf16_t*)(p.ws + WS_XB8), (const bf16_t*)(p.ws + WS_WIN8), NTOK, 40 * 256, DM / 2, gridDim.x, blockIdx.x); S.split = 16; S.off0 = 8; S.off1 = 24;
          EpiInProjT<true> E{p.ws}; pg8::gemm_phase<EpiInProjT<true>, pg8::StaticOrder, true, true>(lds, DM / 2, S, E); }
        { pg8::StaticOrder S; S.init((const bf16_t*)(p.ws + WS_XB), (const bf16_t*)(p.ws + WS_WIN), NTOK, 24 * 256, DM, gridDim.x, blockIdx.x); S.split = 8; S.off0 = 0; S.off1 = 16;
          EpiInProjT<false> E{p.ws}; pg8::gemm_phase<EpiInProjT<false>, pg8::StaticOrder, true, true>(lds, DM, S, E); }
    } else {
        pg8::StaticOrder S; S.init((const bf16_t*)(p.ws + WS_XB), (const bf16_t*)(p.ws + WS_WIN), NTOK, NIN, DM, gridDim.x, blockIdx.x);
        EpiInProjT<false> E{p.ws}; pg8::gemm_phase<EpiInProjT<false>, pg8::StaticOrder, true, true>(lds, DM, S, E);
    }
}
DI void f_proj(const Params& p, LAS unsigned char* lds) {
    unsigned char* ws = p.ws;
    if constexpr (PROJ_FP8) {
    { PairOrder S; S.S0.init((const bf16_t*)(ws + WS_RETA8), (const bf16_t*)(ws + WS_WR), NTOK, DM, DM / 2, gridDim.x, blockIdx.x);
      S.A0 = (const char*)(ws + WS_RETA8); S.A1 = (const char*)(ws + WS_DIFFA8); S.B0 = (const char*)(ws + WS_WR); S.B1 = (const char*)(ws + WS_WD);
      EpiProjPair E{(const bf16_t*)(ws + WS_GATES), (bf16_t*)(ws + WS_MERGED)};
      pg8::gemm_phase<EpiProjPair, PairOrder, true, true>(lds, DM / 2, S, E); }
    } else if constexpr (false) {
    { pg8::StaticOrder S; S.init((const bf16_t*)(ws + WS_RETA8), (const bf16_t*)(ws + WS_WR), NTOK, DM, DM / 2, gridDim.x, blockIdx.x);
      EpiProj<0, true> E{(const bf16_t*)(ws + WS_GATES), nullptr, (bf16_t*)(ws + WS_TMP)};
      pg8::gemm_phase<EpiProj<0, true>, pg8::StaticOrder, true, true>(lds, DM / 2, S, E); }
    { pg8::StaticOrder S; S.init((const bf16_t*)(ws + WS_DIFFA8), (const bf16_t*)(ws + WS_WD), NTOK, DM, DM / 2, gridDim.x, blockIdx.x);
      EpiProj<1, true> E{(const bf16_t*)(ws + WS_GATES), (const bf16_t*)(ws + WS_TMP), (bf16_t*)(ws + WS_MERGED)};
      pg8::gemm_phase<EpiProj<1, true>, pg8::StaticOrder, true, true>(lds, DM / 2, S, E); }
    } else {
    { pg8::StaticOrder S; S.init((const bf16_t*)p.out, (const bf16_t*)(ws + WS_WR), NTOK, DM, DM, gridDim.x, blockIdx.x);
      EpiProj<0> E{(const bf16_t*)(ws + WS_GATES), nullptr, (bf16_t*)(ws + WS_TMP)};
      pg8::gemm_phase<EpiProj<0>, pg8::StaticOrder, true, true>(lds, DM, S, E); }
    { pg8::StaticOrder S; S.init((const bf16_t*)(ws + WS_DIFFA), (const bf16_t*)(ws + WS_WD), NTOK, DM, DM, gridDim.x, blockIdx.x);
      EpiProj<1> E{(const bf16_t*)(ws + WS_GATES), (const bf16_t*)(ws + WS_TMP), (bf16_t*)(ws + WS_MERGED)};
      pg8::gemm_phase<EpiProj<1>, pg8::StaticOrder, true, true>(lds, DM, S, E); }
    }
}
DI void f_outproj(const Params& p, LAS unsigned char* lds) {
    pg8::StaticOrder S; S.init((const bf16_t*)(p.ws + WS_MERGED), (const bf16_t*)(p.ws + WS_WO), NTOK, DM, DM, gridDim.x, blockIdx.x);
    EpiMix E{(bf16_t*)p.out};
    pg8::gemm_phase<EpiMix, pg8::StaticOrder, true, true>(lds, DM, S, E);
}

constexpr int LDS_MOE_TAB = 131072;
constexpr int LDS_MOE_TOK = 131072 + 1024;
template <bool UP> struct MoeOrder {
    static constexpr bool GATHER = UP;
    const char* gbase; const char* A; const char* Bt; int K; size_t estride; int G, c, v;
    LAS const int* tab; LAS const int* tok;
    DI void init(const void* gb, const void* A_, const void* Bt_, int K_, size_t es, LAS unsigned char* lds) { gbase = (const char*)gb; A = (const char*)A_; Bt = (const char*)Bt_; K = K_; estride = es; G = gridDim.x; c = blockIdx.x;
        v = (G % 8 == 0) ? (c % 8) * (G / 8) + c / 8 : c; tab = (LAS const int*)(lds + LDS_MOE_TAB); tok = (LAS const int*)(lds + LDS_MOE_TOK); }
    DI bool next(int i, pg8::Unit& u) const {
        const int L = i * G + v, np = tab[0]; if (L >= np * 8) return false;
        const int panel = L >> 3, nt = L & 7, pk = tab[65 + panel], e = pk >> 8, mt = pk & 255, cnt = tab[1 + e], base = tab[33 + e];
        u.e = e; u.rows = cnt - mt * 256 < 256 ? cnt - mt * 256 : 256; u.rowbase = base + mt * 256; u.slot0 = mt * 256; u.pm = i; u.pn = nt;
        u.A = A + (size_t)u.rowbase * K * 2; u.B = Bt + (size_t)e * estride + (size_t)nt * 256 * K * 2; return true;
    }
    DI unsigned goff(const pg8::Unit& u, int hh, unsigned pk) const { return (unsigned)tok[u.pm * 256 + hh * 128 + (int)(pk >> 8)] * (unsigned)(K * 2) + (pk & 255u) * 2u; }
};
DI void moe_tables(const Params& p, LAS unsigned char* lds) {
    LAS int* tab = (LAS int*)(lds + LDS_MOE_TAB); const int* cnt = (const int*)(p.ws + RT_CNT);
    if (threadIdx.x == 0) { int np = 0, base = 0;
        for (int e = 0; e < NEXP; ++e) { const int c = cnt[e], mt = (c + 255) >> 8; tab[1 + e] = c; tab[33 + e] = base; for (int m = 0; m < mt; ++m) tab[65 + np + m] = e * 256 + m; np += mt; base += mt * 256; }
        tab[0] = np; }
    __syncthreads();
}
struct EpiSwiGLU {
    static constexpr bool PERM = true, FP8 = true; static constexpr bool PAIRED = false; static constexpr int SCALE_W = 0x79797979, SCALE_X = 0x7d7d7d7d;
    unsigned char* act;
    DI void operator()(const f32x4 (&acc)[2][2][4][2], const pg8::Unit& u, int wr, int wc, int fr, int fq) const {
        const int col0 = u.pn * 128 + wc * 32 + 8 * fq;
#pragma unroll
        for (int ai = 0; ai < 2; ++ai)
#pragma unroll
            for (int m = 0; m < 4; ++m) { const int rl = ai * 128 + wr * 64 + m * 16 + fr;
                if (rl < u.rows) { float o[8];
#pragma unroll
                    for (int j = 0; j < 8; ++j) { const float g = acc[ai][0][m][j >> 2][j & 3], up = acc[ai][1][m][j >> 2][j & 3]; o[j] = g * sigmoidf_(g) * up; }
                    *(u32x2*)(act + (size_t)(u.rowbase + rl) * FF + col0) = (u32x2){pk4_fp8(o[0] * F8_SACT, o[1] * F8_SACT, o[2] * F8_SACT, o[3] * F8_SACT), pk4_fp8(o[4] * F8_SACT, o[5] * F8_SACT, o[6] * F8_SACT, o[7] * F8_SACT)}; } }
    }
};
struct EpiDown {
    static constexpr bool PERM = true, FP8 = true; static constexpr bool PAIRED = false; static constexpr int SCALE_W = 0x79797979, SCALE_X = 0x7c7c7c7c;
    bf16_t* ykc;
    DI void operator()(const f32x4 (&acc)[2][2][4][2], const pg8::Unit& u, int wr, int wc, int fr, int fq) const {
        const int col0 = u.pn * 256 + wc * 32 + 8 * fq;
#pragma unroll
        for (int g = 0; g < 8; ++g) { const int ai = g >> 2, m = g & 3, rl = ai * 128 + wr * 64 + m * 16 + fr;
            bf16_t* rowp = ykc + (size_t)(u.rowbase + rl) * DM + col0;
#pragma unroll
            for (int bj = 0; bj < 2; ++bj) { const f32x4 v0 = acc[ai][bj][m][0], v1 = acc[ai][bj][m][1];
                *(u32x4*)(rowp + bj * 128) = (u32x4){pg8::cvt_pk_bf16(v0[0], v0[1]), pg8::cvt_pk_bf16(v0[2], v0[3]), pg8::cvt_pk_bf16(v1[0], v1[1]), pg8::cvt_pk_bf16(v1[2], v1[3])}; } }
    }
};
DI void f_moe_up(const Params& p, LAS unsigned char* lds) {
    unsigned char* ws = p.ws;
    moe_tables(p, lds);
    MoeOrder<true> S; S.init(ws + WS_HB8, nullptr, ws + WS_WGU, DM / 2, (size_t)2048 * DM, lds);
    { LAS int* tok = (LAS int*)(lds + LDS_MOE_TOK); const int* st = (const int*)(ws + RT_SLOTTOK);
      for (int i = 0; i < 5; ++i) { pg8::Unit u; if (S.next(i, u) && threadIdx.x < 256) { int r = threadIdx.x; if (r > u.rows - 1) r = u.rows - 1; tok[i * 256 + threadIdx.x] = st[u.e * NTOK + u.slot0 + r]; } }
      __syncthreads(); }
    EpiSwiGLU E{(unsigned char*)(ws + WS_ACT)};
    pg8::gemm_phase<EpiSwiGLU, MoeOrder<true>, true, true>(lds, DM / 2, S, E);
}
DI void f_moe_down(const Params& p, LAS unsigned char* lds) {
    unsigned char* ws = p.ws;
    moe_tables(p, lds);
    MoeOrder<false> S; S.init(nullptr, ws + WS_ACT, ws + WS_WDN, FF / 2, (size_t)DM * FF, lds);
    EpiDown E{(bf16_t*)(ws + WS_YKC)};
    pg8::gemm_phase<EpiDown, MoeOrder<false>, true, true>(lds, FF / 2, S, E);
}


namespace att {
using bf16 = bf16_t;
constexpr int D = 128, LD = 2048;
constexpr float THR = 8.f;
constexpr bool WSKIP = false;
constexpr float SCALE = 0.08838834764831845f;
constexpr int NW = 8, QBLK = 32, KVBLK = 64, QB = NW * QBLK;
constexpr int SHM_V = KVBLK * D * 2, SHM_K = KVBLK * D * 2;
constexpr int LDS_BYTES = 2 * SHM_V + 2 * SHM_K + NW * 64 * 4;
typedef short s16x4 __attribute__((ext_vector_type(4)));


typedef short s16x4 __attribute__((ext_vector_type(4)));


template <class A, class Bt> struct same_t { static constexpr bool v = false; };
template <class A> struct same_t<A, A> { static constexpr bool v = true; };

#define KSWZ(row, colB) ((row) * 256 + ((colB) ^ (((row) & 7) << 4)))
#define SBAR() __builtin_amdgcn_sched_barrier(0)
__device__ __forceinline__ int v_st(int k, int c) { const int kk = (k & ~0xC) | ((k & 4) << 1) | ((k & 8) >> 1); return ((kk >> 3) * 4 + (c >> 5)) * 512 + ((kk & 7) * 32 + (c & 31)) * 2; }
__device__ __forceinline__ int v_rd_base(int lane) { return ((lane & 3) << 3) | (((lane >> 2) & 3) << 6) | (((lane >> 4) & 1) << 5) | (((lane >> 5) & 1) << 8); }
constexpr int v_rd_off(int d0, int ks, int half) { return d0 * 512 + ks * 4096 + half * 2048; }
__device__ __forceinline__ int crow(int r, int hi) { return (r & 3) + 8 * (r >> 2) + 4 * hi; }
__device__ __forceinline__ unsigned cvtpk(float lo, float hi) {
    unsigned r; asm volatile("v_cvt_pk_bf16_f32 %0, %1, %2" : "=v"(r) : "v"(lo), "v"(hi)); return r;
}
__device__ __forceinline__ bf16x8 pack8(f32x4 a, f32x4 b) {
    u32x4 w = {cvtpk(a[0], a[1]), cvtpk(a[2], a[3]), cvtpk(b[0], b[1]), cvtpk(b[2], b[3])};
    return *reinterpret_cast<bf16x8*>(&w);
}
template <class T> __device__ __forceinline__ bf16x8 load8(const T* p) {
    if constexpr (same_t<T, float>::v) { return pack8(*(const f32x4*)p, *(const f32x4*)(p + 4)); }
    else { return *reinterpret_cast<const bf16x8*>(p); }
}
template <int MODE> __device__ __forceinline__ void mask_tile(f32x16& p0, f32x16& p1, int dq, unsigned W) {
    const float NEG = MODE ? 0.f : -__builtin_inff();
#pragma unroll
    for (int r = 0; r < 16; ++r) {
        const int c = (r & 3) + 8 * (r >> 2);
        if ((unsigned)(dq - c) >= W) p0[r] = NEG;
        if ((unsigned)(dq - c - 32) >= W) p1[r] = NEG;
    }
}
template <int MODE> __device__ __forceinline__ void partialSM(f32x16& p0, f32x16& p1, float& m_reg, float& mn, float& alpha, float fd, float lg) {
    if constexpr (MODE == 1) { alpha = 1.f; mn = 0.f;
        for (int r = 0; r < 16; ++r) { const float c = (float)((r & 3) + 8 * (r >> 2)); p0[r] *= __builtin_amdgcn_exp2f(lg * __builtin_fabsf(fd - c)); }
        return; }
    float pmax = p0[0]; for (int r = 1; r < 16; ++r) pmax = fmaxf(pmax, p0[r]); for (int r = 0; r < 16; ++r) pmax = fmaxf(pmax, p1[r]);
    { auto rr = __builtin_amdgcn_permlane32_swap(__float_as_uint(pmax), __float_as_uint(pmax), false, false);
      pmax = fmaxf(__uint_as_float(rr[0]), __uint_as_float(rr[1])); }
    constexpr float C2 = 1.4426950408889634f * SCALE;
    if (__builtin_expect(__all((pmax - m_reg) * SCALE <= THR), 1)) { mn = m_reg; alpha = 1.f; }
    else { mn = fmaxf(m_reg, pmax); alpha = __builtin_amdgcn_exp2f((m_reg - mn) * C2); m_reg = mn; }
    const float mnL = -mn * C2;
    for (int r = 0; r < 16; ++r) p0[r] = fmaf(p0[r], C2, mnL); for (int r = 0; r < 16; ++r) p1[r] = fmaf(p1[r], C2, mnL);
    for (int r = 0; r < 16; ++r) p0[r] = __builtin_amdgcn_exp2f(p0[r]);
}
template <int MODE> __device__ __forceinline__ void finishSM(f32x16& p0, f32x16& p1, float alpha, float& l_reg, bf16x8& pa0, bf16x8& pa1, bf16x8& pa2, bf16x8& pa3, float fd, float lg) {
    if constexpr (MODE == 1) { for (int r = 0; r < 16; ++r) { const float c = (float)((r & 3) + 8 * (r >> 2) + 32); p1[r] *= __builtin_amdgcn_exp2f(lg * __builtin_fabsf(fd - c)); } }
    else {
    for (int r = 0; r < 16; ++r) p1[r] = __builtin_amdgcn_exp2f(p1[r]);
    float ps = 0; for (int r = 0; r < 16; ++r) ps += p0[r]; for (int r = 0; r < 16; ++r) ps += p1[r];
    { auto rr = __builtin_amdgcn_permlane32_swap(__float_as_uint(ps), __float_as_uint(ps), false, false);
      ps = __uint_as_float(rr[0]) + __uint_as_float(rr[1]); }
    l_reg = l_reg * alpha + ps; }
#define PK4(P, B_, OUT) do { unsigned a0 = cvtpk(P[B_+0], P[B_+1]), a1 = cvtpk(P[B_+2], P[B_+3]);                          \
        unsigned b0 = cvtpk(P[B_+4], P[B_+5]), b1 = cvtpk(P[B_+6], P[B_+7]);                                             \
        auto r0 = __builtin_amdgcn_permlane32_swap(a0, b0, false, false); auto r1 = __builtin_amdgcn_permlane32_swap(a1, b1, false, false); \
        u32x4 w = {r0[0], r1[0], r0[1], r1[1]}; OUT = *reinterpret_cast<bf16x8*>(&w); } while (0)
    PK4(p0, 0, pa0); PK4(p0, 8, pa1); PK4(p1, 0, pa2); PK4(p1, 8, pa3);
#undef PK4
}
template <int KB, bool SK>
__device__ __forceinline__ void qkt(f32x16& p0, f32x16& p1, const char* K_lds, int r32, int hi, const bf16x8* qr, bool act) {
    if (SK && !act) { const float NEG = -__builtin_inff();
#pragma unroll
        for (int r = 0; r < 16; ++r) { p0[r] = NEG; p1[r] = NEG; } return; }
    p0 = f32x16{}; p1 = f32x16{};
    const char* kb[4];
#pragma unroll
    for (int dd = 0; dd < 4; ++dd) kb[dd] = K_lds + KB * SHM_K + KSWZ(r32, (dd * 16 + hi * 8) * 2);
#pragma unroll
    for (int d0 = 0; d0 < 8; ++d0) { const char* a = kb[d0 & 3] + (d0 >> 2) * 128;
        bf16x8 b0 = *reinterpret_cast<const bf16x8*>(a);
        bf16x8 b1 = *reinterpret_cast<const bf16x8*>(a + 32 * 256);
        p0 = __builtin_amdgcn_mfma_f32_32x32x16_bf16(b0, qr[d0], p0, 0, 0, 0);
        p1 = __builtin_amdgcn_mfma_f32_32x32x16_bf16(b1, qr[d0], p1, 0, 0, 0); }
}
template <int VB, bool SK>
__device__ __forceinline__ void pv_tile(f32x16* o, int vb0, bf16x8 pa0, bf16x8 pa1, bf16x8 pa2, bf16x8 pa3, bool act) {
    if (SK && !act) return;
#define TRRD(dst, off) asm volatile("ds_read_b64_tr_b16 %0, %1 offset:%2" : "=&v"(dst) : "v"(vb0), "i"(off) : "memory")
#define PV_D0(d0) do { s16x4 l0, l1, l2, l3, h0, h1, h2, h3; constexpr int b_ = VB * SHM_V + v_rd_off(d0, 0, 0);     \
        TRRD(l0, b_); TRRD(h0, b_ + 2048); TRRD(l1, b_ + 4096); TRRD(h1, b_ + 6144); TRRD(l2, b_ + 8192); TRRD(h2, b_ + 10240); TRRD(l3, b_ + 12288); TRRD(h3, b_ + 14336); \
        asm volatile("s_waitcnt lgkmcnt(0)" ::: "memory"); SBAR();                 \
        o[d0] = __builtin_amdgcn_mfma_f32_32x32x16_bf16(pa0, (bf16x8){l0[0], l0[1], l0[2], l0[3], h0[0], h0[1], h0[2], h0[3]}, o[d0], 0, 0, 0);   \
        o[d0] = __builtin_amdgcn_mfma_f32_32x32x16_bf16(pa1, (bf16x8){l1[0], l1[1], l1[2], l1[3], h1[0], h1[1], h1[2], h1[3]}, o[d0], 0, 0, 0);   \
        o[d0] = __builtin_amdgcn_mfma_f32_32x32x16_bf16(pa2, (bf16x8){l2[0], l2[1], l2[2], l2[3], h2[0], h2[1], h2[2], h2[3]}, o[d0], 0, 0, 0);   \
        o[d0] = __builtin_amdgcn_mfma_f32_32x32x16_bf16(pa3, (bf16x8){l3[0], l3[1], l3[2], l3[3], h3[0], h3[1], h3[2], h3[3]}, o[d0], 0, 0, 0); } while (0)
    PV_D0(0); PV_D0(1); PV_D0(2); PV_D0(3);
#undef PV_D0
#undef TRRD
}

template <class TIn, class TOut> struct BlockRef { const TIn* Q; const TIn* K; const TIn* V; TOut* O; int P0; float lg; int jlo; const unsigned short* s0; };
template <class TIn> struct Seam {
    bf16x8 qr[8];
    bf16x8 st_v0, st_v1, st_k0, st_k1; f32x4 sf0, sf1, sf2, sf3;
    f32x4 tq[16];
};
__device__ __forceinline__ int swa_jlo(int P0, int W) { const int lowk = P0 - W + 1; return lowk > 0 ? lowk / KVBLK : 0; }
#define ROW(p, k0, rr, ld_) ((p) + (size_t)((k0) + (rr)) * (ld_) + sc)
#define VMW() asm volatile("s_waitcnt vmcnt(0)" ::: "memory")
#define VMWN(n) asm volatile("s_waitcnt vmcnt(%0)" :: "i"(n) : "memory")
#define SLOAD_H(Kp, Vp, k0, R_) do { S.st_v0 = load8<TIn>(ROW(Vp, k0, sr, LD)); S.st_v1 = load8<TIn>(ROW(Vp, k0, 32 + sr, LD));              \
                         S.st_k0 = load8<TIn>(ROW(Kp, k0, sr, LD)); S.st_k1 = load8<TIn>(ROW(Kp, k0, 32 + sr, LD)); } while (0)
#define SWRITE_HK(bf) do { *(bf16x8*)(K_lds + (bf) * SHM_K + kws) = S.st_k0; *(bf16x8*)(K_lds + (bf) * SHM_K + kws + 32 * 256) = S.st_k1; } while (0)
#define SWRITE_HV(bf) do { *(bf16x8*)(V_lds + (bf) * SHM_V + vst0) = S.st_v0; *(bf16x8*)(V_lds + (bf) * SHM_V + vst1) = S.st_v1; } while (0)
#define SWRITE_H(bf) do { SWRITE_HV(bf); SWRITE_HK(bf); } while (0)
#define SLOAD_F(p, k0) do { S.sf0 = *(const f32x4*)ROW(p, k0, sr, LD); S.sf1 = *(const f32x4*)(ROW(p, k0, sr, LD) + 4);                \
                            S.sf2 = *(const f32x4*)ROW(p, k0, 32 + sr, LD); S.sf3 = *(const f32x4*)(ROW(p, k0, 32 + sr, LD) + 4); } while (0)
#define SWRITE_KF(bf) do { *(bf16x8*)(K_lds + (bf) * SHM_K + kws) = pack8(S.sf0, S.sf1); *(bf16x8*)(K_lds + (bf) * SHM_K + kws + 32 * 256) = pack8(S.sf2, S.sf3); } while (0)
#define SWRITE_VF(bf) do { *(bf16x8*)(V_lds + (bf) * SHM_V + vst0) = pack8(S.sf0, S.sf1); *(bf16x8*)(V_lds + (bf) * SHM_V + vst1) = pack8(S.sf2, S.sf3); } while (0)
template <class TIn, class TOut>
__device__ __forceinline__ void causal_swa_prime(const BlockRef<TIn, TOut>& cur, int W, char* lds, Seam<TIn>& S) {
    constexpr bool F32 = same_t<TIn, float>::v;
    int tid_ = threadIdx.x; asm volatile("" : "+v"(tid_)); const int tid = tid_, wid = __builtin_amdgcn_readfirstlane(tid >> 6), lane = tid & 63, r32 = lane & 31, hi = lane >> 5;
    const int sr = tid >> 4, sc = (tid & 15) * 8, kws = KSWZ(sr, sc * 2); char* K_lds = lds + 2 * SHM_V;
    const int kb0 = cur.jlo * KVBLK;
    for (int d0 = 0; d0 < 8; ++d0) S.qr[d0] = load8<TIn>(cur.Q + (size_t)(wid * QBLK + r32) * LD + d0 * 16 + hi * 8);
    if constexpr (F32) { SLOAD_F((const float*)cur.K, kb0); VMW(); SWRITE_KF(0); SBAR(); SLOAD_F((const float*)cur.V, kb0); }
    else { SLOAD_H(cur.K, cur.V, kb0, cur); VMW(); SWRITE_HK(0); }
    __syncthreads();
}
template <int MODE, class TIn, class TOut>
__device__ __forceinline__ void causal_swa_block(const BlockRef<TIn, TOut>& cur, const BlockRef<TIn, TOut>& nxt, int skv, int W, char* lds, Seam<TIn>& S) {
    constexpr bool F32 = same_t<TIn, float>::v;
    int tid_ = threadIdx.x; asm volatile("" : "+v"(tid_)); const int tid = tid_, wid = __builtin_amdgcn_readfirstlane(tid >> 6), lane = tid & 63, r32 = lane & 31, hi = lane >> 5;
    const int j_lo = cur.jlo;
    int j_hi = (cur.P0 + QB - 1) / KVBLK + 1; if (j_hi > skv / KVBLK) j_hi = skv / KVBLK;
    const int NT = j_hi - j_lo;
    const int kbn = nxt.jlo * KVBLK;
    const int qlo = cur.P0 + wid * QBLK, qm = ((qlo + r32) | 63) - 4 * hi;
    char* V_lds = lds; char* K_lds = lds + 2 * SHM_V;
    float* ws = (float*)(lds + 2 * SHM_V + 2 * SHM_K) + wid * 64; float* li_l = ws, * al_l = ws + 32;
    float m_reg = -1e30f, l_reg = 0; f32x16 o[4] = {};
    if constexpr (MODE == 1) { if (cur.s0) {
#pragma unroll
        for (int dv = 0; dv < 4; ++dv) {
#pragma unroll
            for (int st = 0; st < 8; ++st) { const bf16x8 sf = *reinterpret_cast<const bf16x8*>(cur.s0 + (size_t)(dv * 32 + r32) * 128 + st * 16 + hi * 8); o[dv] = __builtin_amdgcn_mfma_f32_32x32x16_bf16(S.qr[st], sf, o[dv], 0, 0, 0); } }
#pragma unroll
        for (int r = 0; r < 16; ++r) { const float f = __builtin_amdgcn_exp2f(cur.lg * (float)(cur.P0 + wid * QBLK + crow(r, hi) - j_lo * KVBLK + 1));
#pragma unroll
            for (int dv = 0; dv < 4; ++dv) o[dv][r] *= f; } } }
    const int sr = tid >> 4, sc = (tid & 15) * 8, vst0 = v_st(sr, sc), vst1 = v_st(32 + sr, sc), kws = KSWZ(sr, sc * 2);
    const int vb0 = (int)(uintptr_t)V_lds + v_rd_base(lane);
    const TIn* Kh = cur.K; const TIn* Vh = cur.V;
#define RESC(a) do { if (__any((a) < 1.f)) { if (hi == 0) al_l[r32] = (a); asm volatile("s_waitcnt lgkmcnt(0)" ::: "memory");              \
                     for (int d_ = 0; d_ < 4; ++d_) for (int r = 0; r < 16; ++r) o[d_][r] *= al_l[crow(r, hi)]; } } while (0)
#define KBASE(t) ((j_lo + (t)) * KVBLK)
#define FD(t) ((float)(qlo + r32 - 4 * hi - KBASE(t)))
#define ACT(t) (KBASE(t) <= qlo + QBLK - 1 && KBASE(t) + KVBLK - 1 >= qlo - W + 1)
#define MASKT(P0_, P1_, t) do { const int kb_ = KBASE(t); if ((!SK || ACT(t)) && (kb_ + KVBLK - 1 > qlo || kb_ <= qlo + QBLK - 1 - W)) mask_tile<MODE>(P0_, P1_, qm - kb_, (unsigned)W); } while (0)
    constexpr int NQL = F32 ? 16 : 8;
    constexpr bool SK = WSKIP && !F32;
#define SEAM_K0() do { VMWN(NQL); if constexpr (F32) { SWRITE_KF(0); SBAR(); SLOAD_F((const float*)nxt.V, kbn); } else { SWRITE_HK(0); } SBAR(); } while (0)
    f32x16 pA0, pA1, pB0, pB1; float mnA, mnB, alA, alB; bf16x8 pa0, pa1, pa2, pa3;
    if constexpr (F32) { VMW(); SWRITE_VF(0); SBAR(); } else { SWRITE_HV(0); SBAR(); }
    if (NT > 1) { if constexpr (F32) SLOAD_F((const float*)Kh, KBASE(1)); else SLOAD_H(Kh, Vh, KBASE(1), cur); }
    SBAR(); qkt<0, SK>(pA0, pA1, K_lds, r32, hi, S.qr, ACT(0));
    if constexpr (F32) { if (NT > 1) { VMW(); SWRITE_KF(1); SBAR(); SLOAD_F((const float*)Vh, KBASE(1)); } }
    MASKT(pA0, pA1, 0); partialSM<MODE>(pA0, pA1, m_reg, mnA, alA, FD(0), cur.lg);
    if (NT > 1) { VMW(); if constexpr (F32) { SWRITE_VF(1); SBAR(); if (NT > 2) SLOAD_F((const float*)Kh, KBASE(2)); } else SWRITE_H(1); }
    __syncthreads();
#define HALF_STEP(PX0, PX1, mnX, alX, PY0, PY1, alY, t, KB, VB, SB) do {                                                      \
        SBAR(); qkt<KB, SK>(PX0, PX1, K_lds, r32, hi, S.qr, ACT(t));                                             \
        finishSM<MODE>(PY0, PY1, alY, l_reg, pa0, pa1, pa2, pa3, FD((t) - 1), cur.lg); SBAR();                                                           \
        if ((t) + 1 < NT) { if constexpr (F32) { VMW(); SWRITE_KF(SB); SBAR(); SLOAD_F((const float*)Vh, KBASE((t) + 1)); }  \
                            else { SLOAD_H(Kh, Vh, KBASE((t) + 1), cur); } SBAR(); }                                               \
        pv_tile<VB, SK>(o, vb0, pa0, pa1, pa2, pa3, ACT((t) - 1)); MASKT(PX0, PX1, (t)); partialSM<MODE>(PX0, PX1, m_reg, mnX, alX, FD(t), cur.lg);                                        \
        __syncthreads();                                                                                                      \
        if ((t) + 1 < NT) { VMW(); if constexpr (F32) { SWRITE_VF(SB); SBAR(); if ((t) + 2 < NT) SLOAD_F((const float*)Kh, KBASE((t) + 2)); } \
                            else { SWRITE_H(SB); } }                                                                          \
        RESC(alX); __syncthreads(); } while (0)
    for (int t = 1; t + 1 < NT; t += 2) {
        HALF_STEP(pB0, pB1, mnB, alB, pA0, pA1, alA, t, 1, 0, 0);
        HALF_STEP(pA0, pA1, mnA, alA, pB0, pB1, alB, t + 1, 0, 1, 1);
    }
    const bool even = (NT & 1) == 0;
    if (even) { SBAR(); qkt<1, SK>(pB0, pB1, K_lds, r32, hi, S.qr, ACT(NT - 1)); SBAR(); }
#define QROW(e) (nxt.Q + (size_t)(wid * QBLK + r32) * LD + ((e) >> 1) * 16 + hi * 8 + ((e) & 1) * 4)
    if constexpr (F32) { SLOAD_F((const float*)nxt.K, kbn); SBAR();
#pragma unroll
        for (int e = 0; e < 8; ++e) S.tq[e] = *(const f32x4*)QROW(e); }
    else { SLOAD_H(nxt.K, nxt.V, kbn, nxt); SBAR();
#pragma unroll
        for (int d0 = 0; d0 < 8; ++d0) S.qr[d0] = load8<TIn>(nxt.Q + (size_t)(wid * QBLK + r32) * LD + d0 * 16 + hi * 8); }
    SBAR();
    finishSM<MODE>(pA0, pA1, alA, l_reg, pa0, pa1, pa2, pa3, FD(even ? NT - 2 : NT - 1), cur.lg); SBAR();
    if constexpr (F32) {
#pragma unroll
        for (int e = 8; e < 16; ++e) S.tq[e] = *(const f32x4*)QROW(e); SBAR(); }
#undef QROW
    pv_tile<0, SK>(o, vb0, pa0, pa1, pa2, pa3, ACT(even ? NT - 2 : NT - 1));
    if (even) { MASKT(pB0, pB1, NT - 1); partialSM<MODE>(pB0, pB1, m_reg, mnB, alB, FD(NT - 1), cur.lg); __syncthreads(); RESC(alB);
        finishSM<MODE>(pB0, pB1, alB, l_reg, pa0, pa1, pa2, pa3, FD(NT - 1), cur.lg); SBAR(); pv_tile<1, SK>(o, vb0, pa0, pa1, pa2, pa3, ACT(NT - 1)); }
    SBAR(); SEAM_K0();
    if (hi == 0) li_l[r32] = l_reg; asm volatile("s_waitcnt lgkmcnt(0)" ::: "memory");
    float rli[16];
#pragma unroll
    for (int r = 0; r < 16; ++r) rli[r] = MODE ? 1.f : __builtin_amdgcn_rcpf(li_l[crow(r, hi)]);
    TOut* Ow = cur.O + (size_t)(wid * QBLK) * LD;
#pragma unroll
    for (int r = 0; r < 16; ++r) { const int orow = crow(r, hi);
#pragma unroll
        for (int d0 = 0; d0 < 4; ++d0) { const float v = o[d0][r] * rli[r];
            if constexpr (same_t<TOut, float>::v) { Ow[(size_t)orow * LD + d0 * 32 + r32] = v; }
            else { const float vn = __shfl_xor(v, 1);
                   if ((r32 & 1) == 0) *(unsigned*)(Ow + (size_t)orow * LD + d0 * 32 + r32) = cvtpk(v, vn); } } }
    if constexpr (F32) {
#pragma unroll
        for (int d0 = 0; d0 < 8; ++d0) S.qr[d0] = pack8(S.tq[2 * d0], S.tq[2 * d0 + 1]); }
    __syncthreads();
#undef RESC
#undef KBASE
#undef FD
#undef ACT
#undef MASKT
#undef SEAM_K0
#undef HALF_STEP
}
#undef ROW
#undef VMW
#undef VMWN
#undef SLOAD_H
#undef SWRITE_HK
#undef SWRITE_HV
#undef SWRITE_H
#undef SLOAD_F
#undef SWRITE_KF
#undef SWRITE_VF
}
constexpr int N_RET_ITEMS = 512, N_ATT_ITEMS = 1024;
DI att::BlockRef<bf16_t, bf16_t> mix_ref(const Params& p, int item, int pass) {
    unsigned char* ws = p.ws; att::BlockRef<bf16_t, bf16_t> r;
    if (item < N_RET_ITEMS) { const int prob = item >> 3, x = item & 7, qb = pass ? 15 - x : x; const int vh = prob & 1, h = (prob >> 1) & 7, b = prob >> 4; const size_t t0 = (size_t)b * SEQ;
        r.Q = (const bf16_t*)(ws + WS_RQ) + (t0 + (size_t)qb * 256) * 2048 + h * 128; r.K = (const bf16_t*)(ws + WS_RQ) + t0 * 2048 + 1024 + h * 128;
        r.V = (const bf16_t*)(ws + WS_RV) + t0 * 2048 + h * 256 + vh * 128; r.O = (bf16_t*)p.out + (t0 + (size_t)qb * 256) * 2048 + h * 256 + vh * 128;
        r.P0 = qb * 256; r.lg = log2f(1.f - exp2f(-5.f - (float)h)); const int seg = qb >> 1; r.jlo = seg * 8;
        r.s0 = seg ? (const unsigned short*)((bf16_t*)p.out + (size_t)32 * MiB) + ((size_t)((b * 8 + h) * 7 + seg - 1) * 256 + vh * 128) * 128 : nullptr; return r; }
    item -= N_RET_ITEMS;
    const int prob = item >> 3, x = item & 7, qb = pass ? 15 - x : x;
    const int vh = prob & 1, i = (prob >> 1) & 1, h = (prob >> 2) & 7, b = prob >> 5;
    const size_t t0 = (size_t)b * SEQ, hc = (size_t)h * 256;
    r.Q = (const bf16_t*)(ws + WS_DQ) + (t0 + (size_t)qb * 256) * 2048 + hc + i * 128;
    r.K = (const bf16_t*)(ws + WS_DK) + t0 * 2048 + hc + i * 128;
    r.V = (const bf16_t*)(ws + WS_DV) + t0 * 2048 + hc + vh * 128;
    r.O = (bf16_t*)(ws + (i ? WS_O1 : WS_O0)) + (t0 + (size_t)qb * 256) * 2048 + hc + vh * 128;
    r.P0 = qb * 256; r.lg = 0.f; r.jlo = 0; r.s0 = nullptr;
    return r;
}
template <int MODE> DI void mix_stream(const Params& p, char* lds, int first, int total) {
    constexpr int W = 1 << 30;
    const int stride = gridDim.x; int L = first + blockIdx.x; if (L >= total) return;
    int pass = 0;
    att::BlockRef<bf16_t, bf16_t> cur = mix_ref(p, L, 0);
    att::Seam<bf16_t> S;
    att::causal_swa_prime<bf16_t, bf16_t>(cur, W, lds, S);
    for (;;) {
        const bool more_pass = pass == 0, more_item = L + stride < total, last = !more_pass && !more_item;
        int passn = pass + 1, Ln = L;
        if (!more_pass) { passn = 0; Ln = more_item ? L + stride : L; }
        const att::BlockRef<bf16_t, bf16_t> nxt = last ? cur : mix_ref(p, Ln, passn);
        att::causal_swa_block<MODE, bf16_t, bf16_t>(cur, nxt, SEQ, W, lds, S);
        if (last) break;
        cur = nxt; pass = passn; L = Ln;
    }
}
DI void f_mixers(const Params& p, LAS unsigned char* lds_) {
    char* lds = (char*)lds_;
    mix_stream<1>(p, lds, 0, N_RET_ITEMS);
    __syncthreads();
    mix_stream<0>(p, lds, N_RET_ITEMS, N_RET_ITEMS + N_ATT_ITEMS);
}

namespace mx {
using namespace att;
constexpr int LTAB = 100352;
constexpr int LK0 = 0, LV0 = 32768, LWS = 98304;
struct Blk { const bf16_t* Q; const bf16_t* K; const bf16_t* V; bf16_t* O; unsigned char* O8; const unsigned* k2; int P0, jlo; float lg; const bf16_t* s0; const bf16_t* G; const float* gain; float lam; };

template <int B>
DI void pv256(f32x16* o, int vb0, bf16x8 pa0, bf16x8 pa1, bf16x8 pa2, bf16x8 pa3) {
#define MX_TR(dst, off) asm volatile("ds_read_b64_tr_b16 %0, %1 offset:%2" : "=&v"(dst) : "v"(vb0), "i"(off) : "memory")
#define MX_LOAD(S, d) do { constexpr int b_ = B * 32768 + ((d) >> 2) * 16384 + ((d) & 3) * 512; MX_TR(S##l0, b_); MX_TR(S##h0, b_ + 2048); MX_TR(S##l1, b_ + 4096); MX_TR(S##h1, b_ + 6144); \
        MX_TR(S##l2, b_ + 8192); MX_TR(S##h2, b_ + 10240); MX_TR(S##l3, b_ + 12288); MX_TR(S##h3, b_ + 14336); } while (0)
#define MX_MMA(S, d) do { \
        o[d] = __builtin_amdgcn_mfma_f32_32x32x16_bf16(pa0, (bf16x8){S##l0[0], S##l0[1], S##l0[2], S##l0[3], S##h0[0], S##h0[1], S##h0[2], S##h0[3]}, o[d], 0, 0, 0); \
        o[d] = __builtin_amdgcn_mfma_f32_32x32x16_bf16(pa1, (bf16x8){S##l1[0], S##l1[1], S##l1[2], S##l1[3], S##h1[0], S##h1[1], S##h1[2], S##h1[3]}, o[d], 0, 0, 0); \
        o[d] = __builtin_amdgcn_mfma_f32_32x32x16_bf16(pa2, (bf16x8){S##l2[0], S##l2[1], S##l2[2], S##l2[3], S##h2[0], S##h2[1], S##h2[2], S##h2[3]}, o[d], 0, 0, 0); \
        o[d] = __builtin_amdgcn_mfma_f32_32x32x16_bf16(pa3, (bf16x8){S##l3[0], S##l3[1], S##l3[2], S##l3[3], S##h3[0], S##h3[1], S##h3[2], S##h3[3]}, o[d], 0, 0, 0); } while (0)
#define MX_WAIT() do { asm volatile("s_waitcnt lgkmcnt(0)" ::: "memory"); SBAR(); } while (0)
    s16x4 Al0, Ah0, Al1, Ah1, Al2, Ah2, Al3, Ah3, Bl0, Bh0, Bl1, Bh1, Bl2, Bh2, Bl3, Bh3;
    MX_LOAD(A, 0); MX_WAIT();
    MX_LOAD(B, 1); MX_MMA(A, 0); MX_WAIT();
    MX_LOAD(A, 2); MX_MMA(B, 1); MX_WAIT();
    MX_LOAD(B, 3); MX_MMA(A, 2); MX_WAIT();
    MX_LOAD(A, 4); MX_MMA(B, 3); MX_WAIT();
    MX_LOAD(B, 5); MX_MMA(A, 4); MX_WAIT();
    MX_LOAD(A, 6); MX_MMA(B, 5); MX_WAIT();
    MX_LOAD(B, 7); MX_MMA(A, 6); MX_WAIT();
    MX_MMA(B, 7);
#undef MX_TR
#undef MX_LOAD
#undef MX_MMA
#undef MX_WAIT
}
template <int KB>
DI void qk_first(const char* K_lds, u32x4 kbv, bf16x8& x0, bf16x8& y0, bf16x8& x1, bf16x8& y1) {
    const char* kt = K_lds + KB * SHM_K; const int k0 = (int)kbv[0], k1 = (int)kbv[1];
    x0 = *reinterpret_cast<const bf16x8*>(kt + k0); y0 = *reinterpret_cast<const bf16x8*>(kt + k0 + 32 * 256); x1 = *reinterpret_cast<const bf16x8*>(kt + k1); y1 = *reinterpret_cast<const bf16x8*>(kt + k1 + 32 * 256);
}
template <int KB>
DI void qkt4(f32x16& p0, f32x16& p1, const char* K_lds, u32x4 kbv, const bf16x8* qr, bf16x8 f0, bf16x8 f1, bf16x8 f2, bf16x8 f3) {
    p0 = f32x16{}; p1 = f32x16{};
    int kb[4];
#pragma unroll
    for (int dd = 0; dd < 4; ++dd) kb[dd] = (int)kbv[dd];
    const char* kt = K_lds + KB * SHM_K;
#pragma unroll
    for (int g = 0; g < 4; ++g) { const char* a0 = kt + (kb[(2 * g) & 3] ^ (((2 * g) >> 2) * 128)); const char* a1 = kt + (kb[(2 * g + 1) & 3] ^ (((2 * g + 1) >> 2) * 128));
        bf16x8 x0, y0, x1, y1;
        if (g == 0) { x0 = f0; y0 = f1; x1 = f2; y1 = f3; }
        else { x0 = *reinterpret_cast<const bf16x8*>(a0); y0 = *reinterpret_cast<const bf16x8*>(a0 + 32 * 256); x1 = *reinterpret_cast<const bf16x8*>(a1); y1 = *reinterpret_cast<const bf16x8*>(a1 + 32 * 256); }
        SBAR();
        p0 = __builtin_amdgcn_mfma_f32_32x32x16_bf16(x0, qr[2 * g], p0, 0, 0, 0); p1 = __builtin_amdgcn_mfma_f32_32x32x16_bf16(y0, qr[2 * g], p1, 0, 0, 0);
        p0 = __builtin_amdgcn_mfma_f32_32x32x16_bf16(x1, qr[2 * g + 1], p0, 0, 0, 0); p1 = __builtin_amdgcn_mfma_f32_32x32x16_bf16(y1, qr[2 * g + 1], p1, 0, 0, 0);
        SBAR(); }
}
DI bf16x8 pk8(const f32x16& P, int B_) {
    unsigned a0 = cvtpk(P[B_ + 0], P[B_ + 1]), a1 = cvtpk(P[B_ + 2], P[B_ + 3]), b0 = cvtpk(P[B_ + 4], P[B_ + 5]), b1 = cvtpk(P[B_ + 6], P[B_ + 7]);
    auto r0 = __builtin_amdgcn_permlane32_swap(a0, b0, false, false); auto r1 = __builtin_amdgcn_permlane32_swap(a1, b1, false, false);
    u32x4 w = {r0[0], r1[0], r0[1], r1[1]}; return *reinterpret_cast<bf16x8*>(&w);
}
template <int KB>
DI void qk_first_h0(const char* K_lds, u32x4 kbv, bf16x8& f0, bf16x8& f1, bf16x8& f2, bf16x8& f3) {
    const char* kt = K_lds + KB * SHM_K;
    f0 = *reinterpret_cast<const bf16x8*>(kt + (int)kbv[0]); f1 = *reinterpret_cast<const bf16x8*>(kt + (int)kbv[1]); f2 = *reinterpret_cast<const bf16x8*>(kt + (int)kbv[2]); f3 = *reinterpret_cast<const bf16x8*>(kt + (int)kbv[3]);
}
template <int KB>
DI void qk_att(f32x16& p0, f32x16& p1, const char* K_lds, u32x4 kbv, const bf16x8* qr, bf16x8 f0, bf16x8 f1, bf16x8 f2, bf16x8 f3, float nmb, float& ps, bf16x8& pa0, bf16x8& pa1) {
    constexpr float C2 = 1.4426950408889634f * SCALE;
    const char* kt = K_lds + KB * SHM_K;
#define MX_KF(d0, half) (*reinterpret_cast<const bf16x8*>(kt + (((d0) >> 2) ? ((int)kbv[(d0) & 3] ^ 128) : (int)kbv[(d0) & 3]) + (half) * 8192))
    const bf16x8 b0 = MX_KF(4, 0), b1 = MX_KF(5, 0), b2 = MX_KF(6, 0), b3 = MX_KF(7, 0);
    SBAR();
    p0 = f32x16{};
    p0 = __builtin_amdgcn_mfma_f32_32x32x16_bf16(f0, qr[0], p0, 0, 0, 0); p0 = __builtin_amdgcn_mfma_f32_32x32x16_bf16(f1, qr[1], p0, 0, 0, 0);
    p0 = __builtin_amdgcn_mfma_f32_32x32x16_bf16(f2, qr[2], p0, 0, 0, 0); p0 = __builtin_amdgcn_mfma_f32_32x32x16_bf16(f3, qr[3], p0, 0, 0, 0);
    SBAR();
    const bf16x8 c0 = MX_KF(0, 1), c1 = MX_KF(1, 1), c2 = MX_KF(2, 1), c3 = MX_KF(3, 1);
    SBAR();
    p0 = __builtin_amdgcn_mfma_f32_32x32x16_bf16(b0, qr[4], p0, 0, 0, 0); p0 = __builtin_amdgcn_mfma_f32_32x32x16_bf16(b1, qr[5], p0, 0, 0, 0);
    p0 = __builtin_amdgcn_mfma_f32_32x32x16_bf16(b2, qr[6], p0, 0, 0, 0); p0 = __builtin_amdgcn_mfma_f32_32x32x16_bf16(b3, qr[7], p0, 0, 0, 0);
    SBAR();
    const bf16x8 d0 = MX_KF(4, 1), d1 = MX_KF(5, 1), d2 = MX_KF(6, 1), d3 = MX_KF(7, 1);
    SBAR();
    p1 = f32x16{};
    p1 = __builtin_amdgcn_mfma_f32_32x32x16_bf16(c0, qr[0], p1, 0, 0, 0); p1 = __builtin_amdgcn_mfma_f32_32x32x16_bf16(c1, qr[1], p1, 0, 0, 0);
    p1 = __builtin_amdgcn_mfma_f32_32x32x16_bf16(c2, qr[2], p1, 0, 0, 0); p1 = __builtin_amdgcn_mfma_f32_32x32x16_bf16(c3, qr[3], p1, 0, 0, 0);
#pragma unroll
    for (int r = 0; r < 16; ++r) p0[r] = fmaf(p0[r], C2, nmb);
    SBAR();
    p1 = __builtin_amdgcn_mfma_f32_32x32x16_bf16(d0, qr[4], p1, 0, 0, 0); p1 = __builtin_amdgcn_mfma_f32_32x32x16_bf16(d1, qr[5], p1, 0, 0, 0);
    p1 = __builtin_amdgcn_mfma_f32_32x32x16_bf16(d2, qr[6], p1, 0, 0, 0); p1 = __builtin_amdgcn_mfma_f32_32x32x16_bf16(d3, qr[7], p1, 0, 0, 0);
#pragma unroll
    for (int r = 0; r < 16; ++r) { p0[r] = __builtin_amdgcn_exp2f(p0[r]); ps += p0[r]; }
    pa0 = pk8(p0, 0); pa1 = pk8(p0, 8);
    SBAR();
#undef MX_KF
}
DI void sm_bound_first(f32x16& p0, f32x16& p1, float nmb) {
    constexpr float C2 = 1.4426950408889634f * SCALE;
#pragma unroll
    for (int r = 0; r < 16; ++r) p0[r] = fmaf(p0[r], C2, nmb);
#pragma unroll
    for (int r = 0; r < 16; ++r) p0[r] = __builtin_amdgcn_exp2f(p0[r]);
}
template <int MODE, int EPI>
DI void block(const Blk& c, char* lds) {
    int tid_ = threadIdx.x; asm volatile("" : "+v"(tid_));
    const int tid = tid_, wid = __builtin_amdgcn_readfirstlane(tid >> 6), lane = tid & 63, r32 = lane & 31, hi = lane >> 5;
    char* K_lds = lds + LK0;
    const int vb0 = (int)(uintptr_t)(lds + LV0) + v_rd_base(lane);
    float* ws = (float*)(lds + LWS) + wid * 64; float* li_l = ws; float* al_l = ws + 32;
    unsigned koff[2], voff[4];
#pragma unroll
    for (int i = 0; i < 2; ++i) { const int o = (wid + 8 * i) * 1024 + lane * 16, row = o >> 8, cb = o & 255; koff[i] = (unsigned)(row * (LD * 2) + (cb ^ ((row & 15) << 4))); }
#pragma unroll
    for (int i = 0; i < 4; ++i) { const int q = wid + 8 * i, vh = q >> 4, sub = 2 * (q & 15) + (lane >> 5), kk = (sub >> 2) * 8 + ((lane & 31) >> 2), k = (kk & ~0xC) | ((kk & 4) << 1) | ((kk & 8) >> 1);
        voff[i] = (unsigned)(k * (LD * 2) + (vh * 128 + (sub & 3) * 32 + (lane & 3) * 8) * 2); }
    const int tabp = (int)(uintptr_t)(lds + LTAB) + tid * 48;
    { u32x4 kb4;
#pragma unroll
      for (int dd = 0; dd < 4; ++dd) kb4[dd] = (unsigned)(r32 * 256 + (((dd * 2 + hi) ^ (r32 & 15)) << 4));
      const u32x4 vo4 = {voff[0], voff[1], voff[2], voff[3]}; const u32x2 ko2 = {koff[0], koff[1]};
      asm volatile("ds_write_b128 %0, %1\n\tds_write_b128 %0, %2 offset:16\n\tds_write_b64 %0, %3 offset:32\n\ts_waitcnt lgkmcnt(0)" :: "v"(tabp), "v"(vo4), "v"(kb4), "v"(ko2) : "memory"); }
    const int j_lo = c.jlo, NT = (c.P0 + QB - 1) / KVBLK + 1 - j_lo;
    const int qlo = c.P0 + wid * QBLK, nvis = (qlo >> 6) - j_lo + 1;
#define MX_STAGE(t, b) do { u32x4 vo_; u32x2 ko_; asm volatile("ds_read_b128 %0, %2\n\tds_read_b64 %1, %2 offset:32\n\ts_waitcnt lgkmcnt(0)" : "=&v"(vo_), "=&v"(ko_) : "v"(tabp) : "memory"); const char* kt_ = (const char*)c.K + (size_t)(j_lo + (t)) * (KVBLK * LD * 2); const char* vt_ = (const char*)c.V + (size_t)(j_lo + (t)) * (KVBLK * LD * 2); \
        _Pragma("unroll") for (int i_ = 0; i_ < 2; ++i_) __builtin_amdgcn_global_load_lds((const unsigned*)(kt_ + ko_[i_]), (LAS unsigned*)(lds + LK0 + (b) * 16384 + (wid + 8 * i_) * 1024), 16, 0, 0); \
        _Pragma("unroll") for (int i_ = 0; i_ < 4; ++i_) __builtin_amdgcn_global_load_lds((const unsigned*)(vt_ + vo_[i_]), (LAS unsigned*)(lds + LV0 + (b) * 32768 + (wid + 8 * i_) * 1024), 16, 0, 0); } while (0)
    MX_STAGE(0, 0);
    bf16x8 qr[8];
#pragma unroll
    for (int d0 = 0; d0 < 8; ++d0) qr[d0] = *reinterpret_cast<const bf16x8*>(c.Q + (size_t)(wid * QBLK + r32) * LD + d0 * 16 + hi * 8);
    float m_reg = -1e30f, l_reg = 0.f, nmb = 0.f; f32x16 o[8];
    if constexpr (MODE == 0) { float q2 = 0.f;
#pragma unroll
        for (int d0 = 0; d0 < 8; ++d0)
#pragma unroll
            for (int e = 0; e < 8; ++e) { const float f = bf2f((unsigned)(unsigned short)qr[d0][e]); q2 += f * f; }
        { auto rr = __builtin_amdgcn_permlane32_swap(__float_as_uint(q2), __float_as_uint(q2), false, false); q2 = __uint_as_float(rr[0]) + __uint_as_float(rr[1]); }
        const float k2 = (__uint_as_float(c.k2[0]) + __uint_as_float(c.k2[1])) + (__uint_as_float(c.k2[2]) + __uint_as_float(c.k2[3]));
        nmb = -(sqrtf(q2 * k2) * (1.4426950408889634f * SCALE * 1.02f) + 0.01f); }
#pragma unroll
    for (int d = 0; d < 8; ++d)
#pragma unroll
        for (int r = 0; r < 16; ++r) o[d][r] = 0.f;
    if constexpr (MODE == 1) { if (c.s0) {
#pragma unroll
        for (int dv = 0; dv < 8; ++dv)
#pragma unroll
            for (int st = 0; st < 8; ++st) { const bf16x8 sf = *reinterpret_cast<const bf16x8*>(c.s0 + (size_t)(dv * 32 + r32) * 128 + st * 16 + hi * 8); o[dv] = __builtin_amdgcn_mfma_f32_32x32x16_bf16(qr[st], sf, o[dv], 0, 0, 0); if (st == 7 && (dv & 1)) SBAR(); }
#pragma unroll
        for (int r = 0; r < 16; ++r) { const float f = __builtin_amdgcn_exp2f(c.lg * (float)(qlo + att::crow(r, hi) - j_lo * KVBLK + 1));
#pragma unroll
            for (int dv = 0; dv < 8; ++dv) o[dv][r] *= f; } } }
    if (wid >= 4) __builtin_amdgcn_s_setprio(1);
    asm volatile("s_waitcnt vmcnt(0)" ::: "memory"); __syncthreads();
#define MX_TRD(dst, off) asm volatile("ds_read_b64_tr_b16 %0, %1 offset:%2" : "=&v"(dst) : "v"(vbx_), "i"(off) : "memory")
#define MX_LDH(S, d, KH) do { constexpr int b_ = ((d) >> 2) * 16384 + ((d) & 3) * 512 + (KH) * 8192; MX_TRD(S##a, b_); MX_TRD(S##b, b_ + 2048); MX_TRD(S##c, b_ + 4096); MX_TRD(S##e, b_ + 6144); } while (0)
#define MX_MM2(S, d, PA, PB) do { \
        o[d] = __builtin_amdgcn_mfma_f32_32x32x16_bf16(PA, (bf16x8){S##a[0], S##a[1], S##a[2], S##a[3], S##b[0], S##b[1], S##b[2], S##b[3]}, o[d], 0, 0, 0); \
        o[d] = __builtin_amdgcn_mfma_f32_32x32x16_bf16(PB, (bf16x8){S##c[0], S##c[1], S##c[2], S##c[3], S##e[0], S##e[1], S##e[2], S##e[3]}, o[d], 0, 0, 0); } while (0)
#define MX_LW(n) do { asm volatile("s_waitcnt lgkmcnt(" #n ")" ::: "memory"); SBAR(); } while (0)
#define MX_PASS(KH, PA, PB, F) do { \
        MX_LDH(S0, 0, KH); \
        MX_LDH(S1, 1, KH); MX_LW(4); MX_MM2(S0, 0, PA, PB); F(0); SBAR(); \
        MX_LDH(S0, 2, KH); MX_LW(4); MX_MM2(S1, 1, PA, PB); F(1); SBAR(); \
        MX_LDH(S1, 3, KH); MX_LW(4); MX_MM2(S0, 2, PA, PB); F(2); SBAR(); \
        MX_LDH(S0, 4, KH); MX_LW(4); MX_MM2(S1, 3, PA, PB); F(3); SBAR(); \
        MX_LDH(S1, 5, KH); MX_LW(4); MX_MM2(S0, 4, PA, PB); F(4); SBAR(); \
        MX_LDH(S0, 6, KH); MX_LW(4); MX_MM2(S1, 5, PA, PB); F(5); SBAR(); \
        MX_LDH(S1, 7, KH); MX_LW(4); MX_MM2(S0, 6, PA, PB); F(6); SBAR(); \
        MX_LW(0); MX_MM2(S1, 7, PA, PB); F(7); SBAR(); } while (0)
#define MX_F1(d) do { p1[2 * (d)] = __builtin_amdgcn_exp2f(fmaf(p1[2 * (d)], 1.4426950408889634f * SCALE, nmb)); p1[2 * (d) + 1] = __builtin_amdgcn_exp2f(fmaf(p1[2 * (d) + 1], 1.4426950408889634f * SCALE, nmb)); ps_ += p1[2 * (d)] + p1[2 * (d) + 1]; } while (0)
#define MX_F0(d) do { } while (0)
#define MX_ATT(b) do { const int vbx_ = vb0 + (b) * 32768; s16x4 S0a, S0b, S0c, S0e, S1a, S1b, S1c, S1e; float ps_ = 0.f; \
        qk_att<(b)>(p0, p1, K_lds, kbv_, qr, kf0, kf1, kf2, kf3, nmb, ps_, pa0, pa1); \
        MX_PASS(0, pa0, pa1, MX_F1); \
        pa2 = pk8(p1, 0); pa3 = pk8(p1, 8); \
        { auto rr = __builtin_amdgcn_permlane32_swap(__float_as_uint(ps_), __float_as_uint(ps_), false, false); l_reg += __uint_as_float(rr[0]) + __uint_as_float(rr[1]); } SBAR(); \
        MX_PASS(1, pa2, pa3, MX_F0); } while (0)
#define MX_TILE(t, b) do { bf16x8 kf0, kf1, kf2, kf3; u32x4 kbv_; asm volatile("ds_read_b128 %0, %1 offset:16\n\ts_waitcnt lgkmcnt(0)" : "=&v"(kbv_) : "v"(tabp) : "memory"); if constexpr (MODE == 0) qk_first_h0<(b)>(K_lds, kbv_, kf0, kf1, kf2, kf3); else qk_first<(b)>(K_lds, kbv_, kf0, kf1, kf2, kf3); SBAR();     \
        if ((t) + 1 < NT) MX_STAGE((t) + 1, (b) ^ 1); \
        if ((t) < nvis) { f32x16 p0, p1; float mn, al; bf16x8 pa0, pa1, pa2, pa3; const float fd = (float)(qlo + r32 - 4 * hi - (j_lo + (t)) * KVBLK); \
            if constexpr (MODE == 0) { MX_ATT(b); } \
            else { qkt4<(b)>(p0, p1, K_lds, kbv_, qr, kf0, kf1, kf2, kf3); partialSM<MODE>(p0, p1, m_reg, mn, al, fd, c.lg); finishSM<MODE>(p0, p1, al, l_reg, pa0, pa1, pa2, pa3, fd, c.lg); SBAR(); pv256<(b)>(o, vb0, pa0, pa1, pa2, pa3); } } \
        asm volatile("s_waitcnt vmcnt(0)" ::: "memory"); __syncthreads(); } while (0)
    for (int t = 0; t < NT; t += 2) { MX_TILE(t, 0); if (t + 1 < NT) MX_TILE(t + 1, 1); }
    __builtin_amdgcn_s_setprio(0);
    float rli[16];
    if constexpr (MODE == 0) { if (hi == 0) li_l[r32] = l_reg; asm volatile("s_waitcnt lgkmcnt(0)" ::: "memory");
#pragma unroll
        for (int r = 0; r < 16; ++r) rli[r] = __builtin_amdgcn_rcpf(li_l[att::crow(r, hi)]); }
    else {
#pragma unroll
        for (int r = 0; r < 16; ++r) rli[r] = 1.f; }
    { float* st = (float*)(lds + wid * 8192); const int cg = lane & 31, rs = lane >> 5;
      f32x4 g0 = {1.f, 1.f, 1.f, 1.f}, g1 = g0;
      u32x4 gq[4] = {};
      if constexpr (EPI != 0) { g0 = *(const f32x4*)(c.gain + cg * 8); g1 = *(const f32x4*)(c.gain + cg * 8 + 4);
#pragma unroll
          for (int j = 0; j < 4; ++j) gq[j] = *(const u32x4*)(c.G + (size_t)(wid * QBLK + rs + 2 * j) * LD + cg * 8); }
#pragma unroll 1
      for (int g = 0; g < 4; ++g) {
          u32x4 gn[4] = {};
          if constexpr (EPI != 0) { const int gx = g < 3 ? g + 1 : 3;
#pragma unroll
              for (int j = 0; j < 4; ++j) gn[j] = *(const u32x4*)(c.G + (size_t)(wid * QBLK + 8 * gx + rs + 2 * j) * LD + cg * 8); }
#pragma unroll
          for (int d = 0; d < 8; ++d)
#pragma unroll
              for (int rr = 0; rr < 4; ++rr) { float v = 0.f;
#pragma unroll
                  for (int gg = 0; gg < 4; ++gg) if (gg == g) v = o[d][4 * gg + rr] * rli[4 * gg + rr];
                  st[(rr + 4 * hi) * 256 + d * 32 + r32] = v; }
          asm volatile("s_waitcnt lgkmcnt(0)" ::: "memory");
#pragma unroll
          for (int j = 0; j < 4; ++j) { const int lr = rs + 2 * j; const size_t trow = (size_t)(wid * QBLK + 8 * g + lr);
              const f32x4 xa = *(const f32x4*)(st + lr * 256 + cg * 8), xb = *(const f32x4*)(st + lr * 256 + cg * 8 + 4);
              float x[8] = {xa[0], xa[1], xa[2], xa[3], xb[0], xb[1], xb[2], xb[3]}, y[8];
              if constexpr (EPI == 0) {
#pragma unroll
                  for (int k = 0; k < 8; ++k) y[k] = x[k]; }
              else if constexpr (EPI == 1) { float gt[8]; unpack8(gq[j], gt);
                  float s = 0.f;
#pragma unroll
                  for (int k = 0; k < 8; ++k) s += x[k];
                  const float mean = half_sum(s) * (1.f / 256.f); float q = 0.f;
#pragma unroll
                  for (int k = 0; k < 8; ++k) { x[k] -= mean; q += x[k] * x[k]; }
                  const float rstd = rsqrtf(half_sum(q) * (1.f / 256.f) + LN_EPS);
#pragma unroll
                  for (int k = 0; k < 8; ++k) y[k] = x[k] * rstd * (k < 4 ? g0[k & 3] : g1[k & 3]) * (gt[k] * sigmoidf_(gt[k])); }
              else { float pv[8]; unpack8(gq[j], pv);
                  float ms = 0.f;
#pragma unroll
                  for (int k = 0; k < 8; ++k) { x[k] = pv[k] - c.lam * x[k]; ms += x[k] * x[k]; }
                  const float rsn = rsqrtf(half_sum(ms) * (1.f / 256.f) + LN_EPS) * (1.f - LAMBDA_INIT);
#pragma unroll
                  for (int k = 0; k < 8; ++k) y[k] = x[k] * rsn * (k < 4 ? g0[k & 3] : g1[k & 3]); }
              if constexpr (PROJ_FP8 && EPI != 0) *(u32x2*)(c.O8 + trow * LD + cg * 8) = (u32x2){pk4_fp8(y[0] * F8_SX, y[1] * F8_SX, y[2] * F8_SX, y[3] * F8_SX), pk4_fp8(y[4] * F8_SX, y[5] * F8_SX, y[6] * F8_SX, y[7] * F8_SX)};
              else *(u32x4*)(c.O + trow * LD + cg * 8) = (u32x4){cvtpk(y[0], y[1]), cvtpk(y[2], y[3]), cvtpk(y[4], y[5]), cvtpk(y[6], y[7])}; }
#pragma unroll
          for (int j = 0; j < 4; ++j) gq[j] = gn[j];
          asm volatile("s_waitcnt lgkmcnt(0)" ::: "memory"); } }
    __syncthreads();
#undef MX_STAGE
#undef MX_TRD
#undef MX_LDH
#undef MX_MM2
#undef MX_LW
#undef MX_PASS
#undef MX_F1
#undef MX_F0
#undef MX_ATT
#undef MX_TILE
}
}
DI void f_mixers256(const Params& p, LAS unsigned char* lds_) {
    char* lds = (char*)lds_; unsigned char* ws = p.ws;
    const int G = gridDim.x, vcu = (G % 8 == 0) ? (blockIdx.x % 8) * (G / 8) + blockIdx.x / 8 : blockIdx.x;
    const float lam = ((const float*)(ws + TAB_MISC))[0];
    for (int it = vcu; it < 256; it += G) { const int seg = it & 7, h = (it >> 3) & 7, b = it >> 6; const size_t t0 = (size_t)b * SEQ;
#pragma unroll 1
        for (int half = 0; half < 2; ++half) { const int qb = 2 * seg + half; mx::Blk k; const size_t r0 = (t0 + (size_t)qb * 256) * 2048 + h * 256;
            k.Q = (const bf16_t*)(ws + WS_RQ) + (t0 + (size_t)qb * 256) * 2048 + h * 128; k.K = (const bf16_t*)(ws + WS_RQ) + t0 * 2048 + 1024 + h * 128;
            k.V = (const bf16_t*)(ws + WS_RV) + t0 * 2048 + h * 256; k.O = (bf16_t*)p.out + r0; k.O8 = ws + WS_RETA8 + r0;
            k.P0 = qb * 256; k.jlo = seg * 8; k.lg = log2f(1.f - exp2f(-5.f - (float)h));
            k.s0 = seg ? (const bf16_t*)p.out + (size_t)32 * MiB + (size_t)((b * 8 + h) * 7 + seg - 1) * 256 * 128 : nullptr;
            k.G = (const bf16_t*)(ws + WS_RG) + r0; k.gain = p.ret_gn + h * 256; k.lam = 0.f;
            mx::block<1, 1>(k, lds); } }
    for (int it = vcu; it < 256; it += G) { const int x = it & 7, h = (it >> 3) & 7, b = it >> 6; const size_t t0 = (size_t)b * SEQ, hc = (size_t)h * 256;
#pragma unroll 1
        for (int j = 0; j < 4; ++j) { const int i = j & 1, qb = (j >> 1) ? 15 - x : x; mx::Blk k; const size_t r0 = (t0 + (size_t)qb * 256) * 2048 + hc;
            k.Q = (const bf16_t*)(ws + WS_DQ) + r0 + i * 128; k.K = (const bf16_t*)(ws + WS_DK) + t0 * 2048 + hc + i * 128;
            k.V = (const bf16_t*)(ws + WS_DV) + t0 * 2048 + hc;
            k.P0 = qb * 256; k.jlo = 0; k.lg = 0.f; k.s0 = nullptr; k.G = (const bf16_t*)(ws + WS_O0) + r0; k.gain = p.subln; k.lam = lam;
            k.O8 = ws + WS_DIFFA8 + r0; k.k2 = (const unsigned*)(ws + CW_K2) + ((b * 8 + h) * 2 + i) * 4;
            if (i == 0) { k.O = (bf16_t*)(ws + WS_O0) + r0; mx::block<0, 0>(k, lds); }
            else { k.O = (bf16_t*)(ws + WS_DIFFA) + r0; mx::block<0, 2>(k, lds); } } }
}
typedef short s16x4_t __attribute__((ext_vector_type(4)));
DI void tr_read4(s16x4_t& a, s16x4_t& b, s16x4_t& c, s16x4_t& d, unsigned pa, unsigned pb, unsigned pc, unsigned pd) {
    asm volatile("ds_read_b64_tr_b16 %0, %4\n\tds_read_b64_tr_b16 %1, %5\n\tds_read_b64_tr_b16 %2, %6\n\tds_read_b64_tr_b16 %3, %7\n\ts_waitcnt lgkmcnt(0)"
                 : "=&v"(a), "=&v"(b), "=&v"(c), "=&v"(d) : "v"(pa), "v"(pb), "v"(pc), "v"(pd) : "memory");
}
DI void phase_ret_state(const Params& p, LAS unsigned char* lds) {
    const int tid = threadIdx.x, lane = tid & 63, w = tid >> 6, r32 = lane & 31, hi = lane >> 5;
    const bf16_t* rqk = (const bf16_t*)(p.ws + WS_RQ); const bf16_t* rv = (const bf16_t*)(p.ws + WS_RV);
    bf16_t* s0t = (bf16_t*)p.out + (size_t)32 * MiB;
    constexpr int KB_ = 16384, VB_ = 8192, BUF = KB_ + VB_;
    for (int U = blockIdx.x; U < 128; U += gridDim.x) { const int dvs = U & 3, h = (U >> 2) & 7, b = U >> 5, dvt = w & 1, dkt = w >> 1;
        const float lg = log2f(1.f - exp2f(-5.f - (float)h)), g64 = exp2f(lg * 64.f);
        const bf16_t* kg = rqk + (size_t)b * SEQ * 2048 + 1024 + h * 128; const bf16_t* vg = rv + (size_t)b * SEQ * 2048 + h * 256 + dvs * 64;
        const int kt0 = tid >> 4, kc = tid & 15, vt = tid >> 3, vc = tid & 7;
        const float d0 = exp2f(lg * (float)(63 - kt0)), d1 = exp2f(lg * (float)(63 - kt0 - 32));
        u32x4 rk0 = *(const u32x4*)(kg + (size_t)kt0 * 2048 + kc * 8), rk1 = *(const u32x4*)(kg + (size_t)(kt0 + 32) * 2048 + kc * 8), rvv = *(const u32x4*)(vg + (size_t)vt * 2048 + vc * 8);
        f32x16 acc;
#pragma unroll
        for (int q = 0; q < 16; ++q) acc[q] = 0.f;
        const int i16 = lane & 15, tq = i16 >> 2, tp = i16 & 3, grp = (lane >> 4) & 1;
        const unsigned lbase = (unsigned)(size_t)lds;
        const unsigned aV = lbase + KB_ + (unsigned)((8 * hi + tq) * 128 + (dvt * 32 + 16 * grp + 4 * tp) * 2);
        const unsigned aK = lbase + (unsigned)((8 * hi + tq) * 256 + (dkt * 32 + 16 * grp + 4 * tp) * 2);
        for (int c = 0; c < 56; ++c) { const unsigned bo = (unsigned)(c & 1) * BUF;
            { float f[8]; unpack8(rk0, f); *(LAS u32x4*)(lds + bo + kt0 * 256 + kc * 16) = (u32x4){pk2(f[0] * d0, f[1] * d0), pk2(f[2] * d0, f[3] * d0), pk2(f[4] * d0, f[5] * d0), pk2(f[6] * d0, f[7] * d0)};
              unpack8(rk1, f); *(LAS u32x4*)(lds + bo + (kt0 + 32) * 256 + kc * 16) = (u32x4){pk2(f[0] * d1, f[1] * d1), pk2(f[2] * d1, f[3] * d1), pk2(f[4] * d1, f[5] * d1), pk2(f[6] * d1, f[7] * d1)};
              *(LAS u32x4*)(lds + bo + KB_ + vt * 128 + vc * 16) = rvv; }
            if (c + 1 < 56) { const size_t t1 = (size_t)(c + 1) * 64; rk0 = *(const u32x4*)(kg + (t1 + kt0) * 2048 + kc * 8); rk1 = *(const u32x4*)(kg + (t1 + kt0 + 32) * 2048 + kc * 8); rvv = *(const u32x4*)(vg + (t1 + vt) * 2048 + vc * 8); }
            __syncthreads();
#pragma unroll
            for (int q = 0; q < 16; ++q) acc[q] *= g64;
#pragma unroll
            for (int ks = 0; ks < 4; ++ks) { s16x4_t v0, v1, k0, k1;
                tr_read4(v0, v1, k0, k1, aV + bo + ks * 16 * 128, aV + bo + (ks * 16 + 4) * 128, aK + bo + ks * 16 * 256, aK + bo + (ks * 16 + 4) * 256);
                const bf16x8 af = {v0[0], v0[1], v0[2], v0[3], v1[0], v1[1], v1[2], v1[3]}, bfv = {k0[0], k0[1], k0[2], k0[3], k1[0], k1[1], k1[2], k1[3]};
                acc = MFMA32(af, bfv, acc); }
            if ((c & 7) == 7) { const int s = c >> 3;
#pragma unroll
                for (int q = 0; q < 16; ++q) s0t[((size_t)((b * 8 + h) * 7 + s) * 256 + dvs * 64 + dvt * 32 + crow(q, hi)) * 128 + dkt * 32 + r32] = (bf16_t)f2bf(acc[q]); }
        }
        __syncthreads();
    }
}

#define XB_TMO      128
#define XB_XCNT(j)  (256  + 64 * (j))
#define XB_XSUB(j)  (1280 + 64 * (j))
#define XB_XGEN(j)  (2304 + 64 * (j))
#define XB_TOP      3328
#define XB_TOPGEN   3392
#define XCD_BAR_WORDS 3456
#define XB_SPIN_CAP (1u << 18)

__device__ __forceinline__ unsigned xb_ld(unsigned* p)              { return __hip_atomic_load(p, __ATOMIC_RELAXED, __HIP_MEMORY_SCOPE_AGENT); }
__device__ __forceinline__ unsigned xb_add(unsigned* p, unsigned v) { return __hip_atomic_fetch_add(p, v, __ATOMIC_RELAXED, __HIP_MEMORY_SCOPE_AGENT); }
__device__ __forceinline__ unsigned xb_xcc_id() { return (unsigned)__builtin_amdgcn_s_getreg((3 << 11) | 20) & 0xFu; }
#define XB_SPIN(cond, bar) do { unsigned _sp = 0; while (cond) { __builtin_amdgcn_s_sleep(1); \
    if ((++_sp & 255u) == 0u) { if (xb_ld(&(bar)[XB_TMO])) break; if (_sp > XB_SPIN_CAP) { atomicAdd(&(bar)[XB_TMO], 1u); break; } } } } while (0)

struct XcdBarrier {
    unsigned* bar; unsigned x;
    volatile LAS unsigned* st;
};

__device__ __forceinline__ XcdBarrier xcd_barrier_post(unsigned* bar, volatile LAS unsigned* st) {
    XcdBarrier b; b.bar = bar; b.x = xb_xcc_id(); b.st = st;
    if (threadIdx.x == 0) (void)xb_add(&bar[XB_XCNT(b.x)], 1u);
    return b;
}
__device__ __forceinline__ void xcd_barrier_complete(unsigned* bar, unsigned x, unsigned& nloc, unsigned& nx) {
    const unsigned G = gridDim.x * gridDim.y * gridDim.z;
    unsigned sum, cnt, mine, sp = 0u;
    for (;;) {
        sum = 0u; cnt = 0u; mine = 0u;
#pragma unroll
        for (unsigned j = 0; j < 16; ++j) { const unsigned c = xb_ld(&bar[XB_XCNT(j)]); sum += c; cnt += (c > 0u) ? 1u : 0u; mine = (j == x) ? c : mine; }
        if (sum == G) break;
        __builtin_amdgcn_s_sleep(1);
        if ((++sp & 255u) == 0u) { if (xb_ld(&bar[XB_TMO])) break; if (sp > XB_SPIN_CAP) { atomicAdd(&bar[XB_TMO], 1u); break; } }
    }
    nloc = mine > 0u ? mine : 1u; nx = cnt > 0u ? cnt : 1u;
}

__device__ __forceinline__ void xcd_barrier(const XcdBarrier& b) {
    asm volatile("s_waitcnt vmcnt(0)" ::: "memory");
    __syncthreads();
    if (threadIdx.x == 0) {
        unsigned* bar = b.bar;
        __builtin_amdgcn_s_waitcnt(0);
        unsigned nloc = b.st[0], nx = b.st[1];
        if (nloc == 0u) { xcd_barrier_complete(bar, b.x, nloc, nx); b.st[0] = nloc; b.st[1] = nx; }
        const unsigned old = xb_add(&bar[XB_XSUB(b.x)], 1u);
        const unsigned gen = old / nloc;
        if (old + 1u == (gen + 1u) * nloc) {
            __builtin_amdgcn_fence(__ATOMIC_RELEASE, "agent");
            asm volatile("s_waitcnt vmcnt(0)" ::: "memory");
            const unsigned og = xb_add(&bar[XB_TOP], 1u);
            const unsigned tg = og / nx;
            if (og + 1u == (tg + 1u) * nx) xb_add(&bar[XB_TOPGEN], 1u);
            else XB_SPIN(xb_ld(&bar[XB_TOPGEN]) == tg, bar);
            __builtin_amdgcn_fence(__ATOMIC_ACQUIRE, "agent");
            xb_add(&bar[XB_XGEN(b.x)], 1u);
            asm volatile("s_waitcnt vmcnt(0)" ::: "memory");
        } else {
            XB_SPIN(xb_ld(&bar[XB_XGEN(b.x)]) == gen, bar);
            __builtin_amdgcn_fence(__ATOMIC_ACQUIRE, "agent");
            asm volatile("s_waitcnt vmcnt(0)" ::: "memory");
        }
    }
    __syncthreads();
}

constexpr int NPH = 11;
constexpr bool FAST_GEMM = true, FAST_MOE = true;
constexpr int LDS_BYTES = 147456;
constexpr int LDS_MISC = 131072 + 8192;
constexpr int CW_BAR = 4096;
template <int PH> DI void run_phase(const Params& p, LAS unsigned char* lds) {
    if constexpr (PH == 0) phase_prep(p, lds);
    if constexpr (PH == 1) { if constexpr (FAST_GEMM) f_inproj(p, lds); else n_inproj(p); }
    if constexpr (PH == 2) { if constexpr (MIX256) f_mixers256(p, lds); else if constexpr (FAST_ATTN) f_mixers(p, lds); else n_mixers(p, lds); }
    if constexpr (PH == 3) phase_norms(p);
    if constexpr (PH == 4) { if constexpr (FAST_GEMM) f_proj(p, lds); else n_proj(p); }
    if constexpr (PH == 5) { if constexpr (FAST_GEMM) f_outproj(p, lds); else n_outproj(p); }
    if constexpr (PH == 6) phase_ln1_router(p);
    if constexpr (PH == 7) {   }
    if constexpr (PH == 8) { if constexpr (FAST_MOE) f_moe_up(p, lds); else n_moe_up(p); }
    if constexpr (PH == 9) { if constexpr (FAST_MOE) f_moe_down(p, lds); else n_moe_down(p); }
    if constexpr (PH == 10) phase_final(p);
    if constexpr (PH == 11) { if constexpr (FAST_ATTN) { phase_ret_state(p, lds); prep_fill_rs(p, lds); } }
}
template <int LO, int HI> __global__ void __launch_bounds__(512, 2) k_range(Params p) {
    extern __shared__ __attribute__((aligned(16))) unsigned char lds_raw[];
    LAS unsigned char* lds = (LAS unsigned char*)lds_raw;
    XcdBarrier bar; bar.bar = nullptr; bar.x = 0; bar.st = nullptr;
    if constexpr (HI - LO > 1) {
        volatile LAS unsigned* misc = (volatile LAS unsigned*)(lds + LDS_MISC);
        if (threadIdx.x < 4) misc[threadIdx.x] = 0u;
        __syncthreads();
        bar = xcd_barrier_post((unsigned*)(p.ws + WS_CTL) + CW_BAR, misc);
    }
#ifndef REPEAT_MASK
#define REPEAT_MASK 0
#endif
#define PHASE(k) if constexpr (LO <= (k) && (k) < HI) { run_phase<(k)>(p, lds); if constexpr ((REPEAT_MASK >> (k)) & 1) { xcd_barrier(bar); run_phase<(k)>(p, lds); } if constexpr ((k) + 1 < HI) xcd_barrier(bar); }
    PHASE(0) PHASE(1) if constexpr (LO <= 1 && 2 < HI) { run_phase<11>(p, lds); xcd_barrier(bar); if constexpr ((REPEAT_MASK >> 11) & 1) { run_phase<11>(p, lds); xcd_barrier(bar); } } PHASE(2) PHASE(4) PHASE(5) PHASE(6) PHASE(8) PHASE(9) PHASE(10)
#undef PHASE
}
#ifndef N_LAUNCHES
#define N_LAUNCHES 1
#endif
template <int LO, int HI> static void launch_range(const Params& p, hipStream_t stream) {
    static int grid = 0;
    if (!grid) {
        (void)hipFuncSetAttribute((const void*)k_range<LO, HI>, hipFuncAttributeMaxDynamicSharedMemorySize, LDS_BYTES);
        int dev = 0, cus = 0, per_cu = 0; (void)hipGetDevice(&dev); (void)hipDeviceGetAttribute(&cus, hipDeviceAttributeMultiprocessorCount, dev);
        if (hipOccupancyMaxActiveBlocksPerMultiprocessor(&per_cu, (const void*)k_range<LO, HI>, 512, LDS_BYTES) != hipSuccess || per_cu < 1) { fprintf(stderr, "occupancy query: %d blocks per CU\n", per_cu); (void)hipGetLastError(); }
        grid = cus > 0 ? cus : 256;
    }
    hipLaunchKernelGGL((k_range<LO, HI>), dim3(grid), dim3(512), LDS_BYTES, stream, p);
}

extern "C" void kernel_launch(void* const* d_in, const int* in_sizes, int n_in, void* d_out, int out_size, void* d_ws, size_t ws_size, hipStream_t stream) {
    if (n_in != 23 || out_size != NTOK * DM || ws_size < WS_END) { fprintf(stderr, "kernel_launch: unexpected shapes (n_in %d out %d ws %zu need %zu)\n", n_in, out_size, ws_size, (size_t)WS_END); return; }
    Params p{};
    p.x = (const float*)d_in[0]; p.pos = (const int*)d_in[1]; p.w_in = (const float*)d_in[2]; p.ret_gn = (const float*)d_in[3];
    p.lq1 = (const float*)d_in[4]; p.lk1 = (const float*)d_in[5]; p.lq2 = (const float*)d_in[6]; p.lk2 = (const float*)d_in[7]; p.subln = (const float*)d_in[8];
    p.w_ret_proj = (const float*)d_in[9]; p.w_diff_proj = (const float*)d_in[10]; p.w_out = (const float*)d_in[11]; p.ln1g = (const float*)d_in[12]; p.ln1b = (const float*)d_in[13];
    p.w_group = (const float*)d_in[14]; p.b_group = (const float*)d_in[15]; p.w_router = (const float*)d_in[16]; p.b_router = (const float*)d_in[17];
    p.w_gate = (const float*)d_in[18]; p.w_up = (const float*)d_in[19]; p.w_down = (const float*)d_in[20]; p.ln2g = (const float*)d_in[21]; p.ln2b = (const float*)d_in[22];
    p.out = (float*)d_out; p.ws = (unsigned char*)d_ws;
    (void)hipMemsetAsync((char*)d_ws + WS_CTL, 0, 1 * MiB, stream);
#if N_LAUNCHES == 1
    launch_range<0, NPH>(p, stream);
#else
    launch_range<0, 1>(p, stream); launch_range<1, 2>(p, stream); launch_range<2, 3>(p, stream); launch_range<3, 4>(p, stream); launch_range<4, 5>(p, stream); launch_range<5, 6>(p, stream);
    launch_range<6, 7>(p, stream); launch_range<7, 8>(p, stream); launch_range<8, 9>(p, stream); launch_range<9, 10>(p, stream); launch_range<10, 11>(p, stream);
#endif
}
```

```cpp
#include <hip/hip_runtime.h>
#include <cstdio>
#include <cstdint>

#define DI __device__ __forceinline__
#define LAS __attribute__((address_space(3)))
typedef unsigned short bf16_t;
typedef short bf16x8 __attribute__((ext_vector_type(8)));
typedef float f32x4 __attribute__((ext_vector_type(4)));
typedef float f32x16 __attribute__((ext_vector_type(16)));
typedef unsigned u32x4 __attribute__((ext_vector_type(4)));
typedef unsigned u32x2 __attribute__((ext_vector_type(2)));
#define MFMA32(a, b, c) __builtin_amdgcn_mfma_f32_32x32x16_bf16((a), (b), (c), 0, 0, 0)

constexpr int NTOK = 16384, SEQ = 4096, DM = 2048, NIN = 16384, NEXP = 32, FF = 1024;
constexpr float ALPHA = 1.189207115002721f;
constexpr float LN_EPS = 1e-5f;
constexpr float QK_SCALE = 0.08838834764831845f;
constexpr float LOG2E = 1.4426950408889634f;
constexpr float LAMBDA_INIT = 0.2f;

constexpr size_t MiB = 1ull << 20;
constexpr size_t WS_CTL = 0;
constexpr size_t WS_TAB = 2 * MiB;
constexpr size_t WS_ROUTE = 12 * MiB;
constexpr size_t WS_WR = 20 * MiB, WS_WD = 28 * MiB, WS_WO = 36 * MiB;
constexpr size_t WS_WGU = 44 * MiB;
constexpr size_t WS_WDN = 300 * MiB;
constexpr size_t WS_XB = 428 * MiB, WS_WIN = 492 * MiB;
constexpr size_t WS_RQ = 556 * MiB, WS_RK = 588 * MiB, WS_RV = 620 * MiB, WS_RG = 684 * MiB, WS_DQ = 748 * MiB, WS_DK = 812 * MiB, WS_DV = 876 * MiB, WS_GATES = 940 * MiB;
constexpr size_t WS_END = 1068 * MiB;
constexpr size_t WS_O0 = WS_XB, WS_O1 = WS_WIN;
constexpr size_t WS_ACT = WS_XB;
constexpr size_t WS_DIFFA = WS_WIN;
constexpr size_t WS_TMP = WS_RQ;
constexpr size_t WS_MERGED = WS_RV;
constexpr size_t WS_HB = WS_DV;
constexpr bool GATES_FP8 = true;
constexpr size_t WS_XB8 = 172 * MiB, WS_WIN8 = 204 * MiB;
constexpr bool PROJ_FP8 = true;
constexpr size_t WS_RETA8 = WS_XB8, WS_DIFFA8 = WS_WIN8;
constexpr size_t WS_HB8 = WS_DQ;
constexpr size_t WS_YKC = WS_RQ;
constexpr size_t WS_YK = WS_GATES;
constexpr size_t TAB_COSR = WS_TAB, TAB_SINR = WS_TAB + 4 * MiB, TAB_COSD = WS_TAB + 8 * MiB, TAB_SIND = WS_TAB + 9 * MiB, TAB_MISC = WS_TAB + 10 * MiB;
constexpr size_t CW_K2 = WS_CTL + 65536 + 1024;
constexpr size_t RT_TOKE = WS_ROUTE, RT_TOKW = WS_ROUTE + 128 * 1024, RT_CNT = WS_CTL + 65536  , RT_SLOTTOK = WS_ROUTE + 1 * MiB, RT_SLOTW = WS_ROUTE + 3 * MiB,
                 RT_SLOTDST = WS_ROUTE + 5 * MiB, RT_WRT = WS_ROUTE + 7 * MiB  ;

struct Params {
    const float* x; const int* pos; const float* w_in; const float* ret_gn; const float* lq1; const float* lk1; const float* lq2; const float* lk2; const float* subln;
    const float* w_ret_proj; const float* w_diff_proj; const float* w_out; const float* ln1g; const float* ln1b; const float* w_group; const float* b_group;
    const float* w_router; const float* b_router; const float* w_gate; const float* w_up; const float* w_down; const float* ln2g; const float* ln2b;
    float* out; unsigned char* ws;
};

constexpr bool FAST_ATTN = true, MIX256 = true;
DI unsigned f2bf(float f) { unsigned u = __float_as_uint(f); return (u + 0x7fffu + ((u >> 16) & 1u)) >> 16; }
DI float bf2f(unsigned b) { return __uint_as_float(b << 16); }
DI unsigned pk4_fp8(float a, float b, float c, float d) {
    a = fminf(fmaxf(a, -448.f), 448.f); b = fminf(fmaxf(b, -448.f), 448.f); c = fminf(fmaxf(c, -448.f), 448.f); d = fminf(fmaxf(d, -448.f), 448.f);
    int w = __builtin_amdgcn_cvt_pk_fp8_f32(a, b, 0, false); w = __builtin_amdgcn_cvt_pk_fp8_f32(c, d, w, true); return (unsigned)w; }
constexpr float F8_SX = 4.f, F8_SW = 64.f, F8_SACT = 8.f;
DI unsigned pk2(float lo, float hi) { unsigned r; asm volatile("v_cvt_pk_bf16_f32 %0, %1, %2" : "=v"(r) : "v"(lo), "v"(hi)); return r; }
DI int crow(int reg, int h) { return (reg & 3) + 8 * (reg >> 2) + 4 * h; }
DI float wave_sum(float v) {
#define WS_DPP(ctrl) v += __int_as_float(__builtin_amdgcn_update_dpp(0, __float_as_int(v), (ctrl), 0xf, 0xf, true))
    WS_DPP(0xB1);
    WS_DPP(0x4E);
    WS_DPP(0x141);
    WS_DPP(0x140);
#undef WS_DPP
    const int b = __float_as_int(v);
    return (__int_as_float(__builtin_amdgcn_readlane(b, 0)) + __int_as_float(__builtin_amdgcn_readlane(b, 16))) + (__int_as_float(__builtin_amdgcn_readlane(b, 32)) + __int_as_float(__builtin_amdgcn_readlane(b, 48)));
}
DI float sigmoidf_(float v) { return 1.f / (1.f + __expf(-v)); }
DI void unpack8(const u32x4 w, float (&f)[8]) { f[0] = bf2f(w.x & 0xffff); f[1] = bf2f(w.x >> 16); f[2] = bf2f(w.y & 0xffff); f[3] = bf2f(w.y >> 16); f[4] = bf2f(w.z & 0xffff); f[5] = bf2f(w.z >> 16); f[6] = bf2f(w.w & 0xffff); f[7] = bf2f(w.w >> 16); }
DI int inproj_dst_row(int c) {
    if (c < 2048) { const int w = c & 127, base = c - w, s = w >> 6, i = w & 63; return base + 2 * i + s; }
    if (c >= 6144 && c < 10240) { const int w = c & 127, base = c - w; if (w < 32) { const int s = w >> 4, i = w & 15; return base + 2 * i + s; } return c; }
    return c;
}
struct SegInfo { bf16_t* base; int ld; int cl; int rope; float scale; };
DI SegInfo seg_of(unsigned char* ws, int n) {
    SegInfo s; s.rope = 0; s.scale = 1.f;
    if (n < 1024) { s.base = (bf16_t*)(ws + WS_RQ); s.ld = 2048; s.cl = n; s.rope = 1; }
    else if (n < 2048) { s.base = (bf16_t*)(ws + WS_RQ); s.ld = 2048; s.cl = n; s.rope = 1; s.scale = QK_SCALE; }
    else if (n < 4096) { s.base = (bf16_t*)(ws + WS_RV); s.ld = 2048; s.cl = n - 2048; }
    else if (n < 6144) { s.base = (bf16_t*)(ws + WS_RG); s.ld = 2048; s.cl = n - 4096; }
    else if (n < 8192) { s.base = (bf16_t*)(ws + WS_DQ); s.ld = 2048; s.cl = n - 6144; s.rope = 2; }
    else if (n < 10240) { s.base = (bf16_t*)(ws + WS_DK); s.ld = 2048; s.cl = n - 8192; s.rope = 2; }
    else if (n < 12288) { s.base = (bf16_t*)(ws + WS_DV); s.ld = 2048; s.cl = n - 10240; }
    else { s.base = (bf16_t*)(ws + WS_GATES); s.ld = 4096; s.cl = n - 12288; }
    return s;
}

#ifndef PREP_TK
#define PREP_TK 64
#endif
constexpr int TK = PREP_TK, TN = 8192 / TK;
struct TItem { const float* src; bf16_t* dst; int ld, ldd, k0, n0, mode, f8; };
DI int titem_row(const TItem& t, int n) { return t.mode == 0 ? n : (t.mode == 1 ? inproj_dst_row(n) : (t.mode == 4 ? n : (n >> 7) * 256 + (n & 127) + (t.mode - 2) * 128)); }
constexpr int I_IN = (DM / TK) * (NIN / TN), I_SQ = (DM / TK) * (DM / TN), I_E = (DM / TK) * (FF / TN)  , I_D = (FF / TK) * (DM / TN);
constexpr int PREP_ITEMS = I_IN + 3 * I_SQ + NEXP * (2 * I_E + I_D);
DI TItem titem_decode(const Params& p, int it) {
    unsigned char* ws = p.ws; TItem t; int r = it;
    if (r < I_IN) { t.src = p.w_in; t.ld = NIN; t.dst = (bf16_t*)(ws + WS_WIN); t.ldd = DM; t.k0 = (r / (NIN / TN)) * TK; t.n0 = (r % (NIN / TN)) * TN; t.mode = 1; t.f8 = 0;
        if (GATES_FP8 && (t.n0 >= 10240 || (t.n0 >= 2048 && t.n0 < 6144))) { t.dst = (bf16_t*)(ws + WS_WIN8); t.mode = 4; t.f8 = 1; } return t; } r -= I_IN;
    if (r < 3 * I_SQ) { const int m = r / I_SQ, q = r % I_SQ; t.src = m == 0 ? p.w_ret_proj : (m == 1 ? p.w_diff_proj : p.w_out); t.dst = (bf16_t*)(ws + (m == 0 ? WS_WR : (m == 1 ? WS_WD : WS_WO)));
        t.ld = DM; t.ldd = DM; t.k0 = (q / (DM / TN)) * TK; t.n0 = (q % (DM / TN)) * TN; t.mode = 0; t.f8 = (PROJ_FP8 && m < 2) ? 1 : 0; return t; } r -= 3 * I_SQ;
    const int e = r / (2 * I_E + I_D); int q = r % (2 * I_E + I_D);
    if (q < 2 * I_E) { const int up = q / I_E; q %= I_E; t.src = (up ? p.w_up : p.w_gate) + (size_t)e * DM * FF; t.dst = (bf16_t*)(ws + WS_WGU + (size_t)e * 2048 * DM); t.ld = FF; t.ldd = DM; t.k0 = (q / (FF / TN)) * TK; t.n0 = (q % (FF / TN)) * TN; t.mode = 2 + up; t.f8 = 1; return t; }
    q -= 2 * I_E;
    t.src = p.w_down + (size_t)e * FF * DM; t.dst = (bf16_t*)(ws + WS_WDN + (size_t)e * DM * FF); t.ld = DM; t.ldd = FF; t.k0 = (q / (DM / TN)) * TK; t.n0 = (q % (DM / TN)) * TN; t.mode = 0; t.f8 = 1; return t;
}
DI void titem_load(const TItem& t, f32x4 (&r)[4]) {
    const int tid = threadIdx.x, k = tid / (TN / 4), n4 = tid % (TN / 4);
#pragma unroll
    for (int i = 0; i < 4; ++i) r[i] = __builtin_nontemporal_load((const f32x4*)(t.src + (size_t)(t.k0 + k + (TK / 4) * i) * t.ld + t.n0 + 4 * n4));
}
DI void prep_range(const Params& p, LAS unsigned char* lds, int first, int step, int n) {
    LAS float* tile = (LAS float*)lds;
    const int tid = threadIdx.x;
    if (n <= 0) return;
    { int it = first, left = n - 1; TItem cur = titem_decode(p, it); f32x4 r[4]; titem_load(cur, r);
      for (;;) {
        const int nx = it + step; const bool has = left > 0; TItem nt = cur; f32x4 r2[4];
        if (has) { nt = titem_decode(p, nx); titem_load(nt, r2); }
        { const int k = tid / (TN / 4), n4 = tid % (TN / 4);
#pragma unroll
          for (int i = 0; i < 4; ++i)
#pragma unroll
              for (int j = 0; j < 4; ++j) tile[(k + (TK / 4) * i) * (TN + 1) + 4 * n4 + j] = r[i][j]; }
        __syncthreads();
        { const int n_ = tid / (TK / 16), part = tid % (TK / 16);
          if (cur.f8) { unsigned w[4];
#pragma unroll
              for (int j = 0; j < 4; ++j) w[j] = pk4_fp8(tile[(part * 16 + 4 * j) * (TN + 1) + n_] * F8_SW, tile[(part * 16 + 4 * j + 1) * (TN + 1) + n_] * F8_SW, tile[(part * 16 + 4 * j + 2) * (TN + 1) + n_] * F8_SW, tile[(part * 16 + 4 * j + 3) * (TN + 1) + n_] * F8_SW);
              *(u32x4*)((unsigned char*)cur.dst + (size_t)titem_row(cur, cur.n0 + n_) * cur.ldd + cur.k0 + part * 16) = (u32x4){w[0], w[1], w[2], w[3]}; }
          else { unsigned w[8];
#pragma unroll
              for (int j = 0; j < 8; ++j) w[j] = pk2(tile[(part * 16 + 2 * j) * (TN + 1) + n_], tile[(part * 16 + 2 * j + 1) * (TN + 1) + n_]);
              bf16_t* d = cur.dst + (size_t)titem_row(cur, cur.n0 + n_) * cur.ldd + cur.k0 + part * 16;
              *(u32x4*)d = (u32x4){w[0], w[1], w[2], w[3]}; *(u32x4*)(d + 8) = (u32x4){w[4], w[5], w[6], w[7]}; } }
        __syncthreads();
        if (!has) break;
        cur = nt; it = nx; --left;
#pragma unroll
        for (int i = 0; i < 4; ++i) r[i] = r2[i];
      } }
}
constexpr int FILL_RS = 10, FILL_RS_ITEMS = FILL_RS * 128, FILL_SK_ITEMS = 32 * 3 * 28, FILL_ITEMS = FILL_RS_ITEMS + FILL_SK_ITEMS;
DI void prep_fill_rs(const Params& p, LAS unsigned char* lds) {
    if (gridDim.x != 256 || blockIdx.x < 128) return;
    prep_range(p, lds, PREP_ITEMS - FILL_ITEMS + ((int)blockIdx.x - 128), 128, FILL_RS);
}
DI void prep_fill_skew(const Params& p, LAS unsigned char* lds) {
    const int g = (blockIdx.x >> 3) & 7, j = (blockIdx.x & 7) + 8 * (blockIdx.x >> 6);
    prep_range(p, lds, PREP_ITEMS - FILL_SK_ITEMS + 48 * g * (g - 1) + j, 32, 3 * g);
}
DI void phase_prep(const Params& p, LAS unsigned char* lds) {
    unsigned char* ws = p.ws;
    const int tid = threadIdx.x, G = gridDim.x, bid = blockIdx.x;
    { const int n0 = (G == 256) ? PREP_ITEMS - FILL_ITEMS : PREP_ITEMS; constexpr int NW0 = I_IN + 3 * I_SQ;
      prep_range(p, lds, NW0 + bid, G, (n0 - NW0 - bid + G - 1) / G);
      prep_range(p, lds, bid, G, (NW0 - bid + G - 1) / G); }
    { const size_t n8 = (size_t)NTOK * DM / 8; bf16_t* xb = (bf16_t*)(ws + WS_XB);
      for (size_t i = (size_t)bid * 512 + tid; i < n8; i += (size_t)G * 512) { const f32x4 a = __builtin_nontemporal_load((const f32x4*)(p.x + i * 8)), b = __builtin_nontemporal_load((const f32x4*)(p.x + i * 8 + 4));
          *(u32x4*)(xb + i * 8) = (u32x4){pk2(a[0], a[1]), pk2(a[2], a[3]), pk2(b[0], b[1]), pk2(b[2], b[3])};
          if (GATES_FP8) *(u32x2*)(ws + WS_XB8 + i * 8) = (u32x2){pk4_fp8(a[0] * F8_SX, a[1] * F8_SX, a[2] * F8_SX, a[3] * F8_SX), pk4_fp8(b[0] * F8_SX, b[1] * F8_SX, b[2] * F8_SX, b[3] * F8_SX)}; } }
    { float* cosR = (float*)(ws + TAB_COSR); float* sinR = (float*)(ws + TAB_SINR); float* cosD = (float*)(ws + TAB_COSD); float* sinD = (float*)(ws + TAB_SIND);
      LAS float* invf = (LAS float*)lds;
      __syncthreads();
      if (tid < 64) invf[tid] = (float)(1.0 / pow(10000.0, (double)(2 * tid) / 128.0)); else if (tid < 80) invf[tid] = (float)(1.0 / pow(500000.0, (double)(2 * (tid - 64)) / 32.0));
      __syncthreads();
      for (int i = bid * 512 + tid; i < NTOK * 80; i += G * 512) { const int t = i / 80, f = i % 80; const float ang = (float)p.pos[t] * invf[f];
          const double a = (double)ang, k = rint(a * 0.15915494309189535); const float r = (float)((a - k * 6.283185307179586) - k * 2.4492935982947064e-16);
          const float s = sinf(r), c = cosf(r);
          if (f < 64) { cosR[t * 64 + f] = c; sinR[t * 64 + f] = s; } else { cosD[t * 16 + f - 64] = c; sinD[t * 16 + f - 64] = s; } } }
    { float* wrt = (float*)(ws + RT_WRT);
      for (int i = bid * 512 + tid; i < 36 * DM; i += G * 512) { const int e = i / DM, k = i % DM; wrt[i] = e < 4 ? p.w_group[k * 4 + e] : p.w_router[k * 32 + (e - 4)]; }
      if (bid == 0 && tid < 36) wrt[36 * DM + tid] = tid < 4 ? p.b_group[tid] : p.b_router[tid - 4]; }
    if (bid == 0 && tid < 64) { float a = 0.f, b = 0.f; for (int i = tid; i < 128; i += 64) { a += p.lq1[i] * p.lk1[i]; b += p.lq2[i] * p.lk2[i]; }
        a = wave_sum(a); b = wave_sum(b); if (tid == 0) ((float*)(ws + TAB_MISC))[0] = expf(a) - expf(b) + LAMBDA_INIT; }
}

template <class AF, class BF>
DI void sgemm64(f32x16 (&acc)[2][2], AF arow, BF brow, int K, int lane) {
    const int r = lane & 31, h = lane >> 5;
    const bf16_t* pa0 = arow(r) + 8 * h; const bf16_t* pa1 = arow(32 + r) + 8 * h;
    const bf16_t* pb0 = brow(r) + 8 * h; const bf16_t* pb1 = brow(32 + r) + 8 * h;
#pragma unroll
    for (int i = 0; i < 2; ++i)
#pragma unroll
        for (int j = 0; j < 2; ++j)
#pragma unroll
            for (int q = 0; q < 16; ++q) acc[i][j][q] = 0.f;
#pragma unroll 4
    for (int k0 = 0; k0 < K; k0 += 16) {
        const bf16x8 a0 = *(const bf16x8*)(pa0 + k0), a1 = *(const bf16x8*)(pa1 + k0), b0 = *(const bf16x8*)(pb0 + k0), b1 = *(const bf16x8*)(pb1 + k0);
        acc[0][0] = MFMA32(a0, b0, acc[0][0]); acc[0][1] = MFMA32(a0, b1, acc[0][1]); acc[1][0] = MFMA32(a1, b0, acc[1][0]); acc[1][1] = MFMA32(a1, b1, acc[1][1]);
    }
}

DI void inproj_store_elem(const Params& p, int t, int n, float v, float pv) {
    const SegInfo s = seg_of(p.ws, n); const int w = s.cl & 127; float o = v;
    if (s.rope == 1) { const int i = w >> 1; const float c = ((const float*)(p.ws + TAB_COSR))[t * 64 + i], sn = ((const float*)(p.ws + TAB_SINR))[t * 64 + i]; o = (w & 1) ? v * c + pv * sn : v * c - pv * sn; }
    else if (s.rope == 2 && w < 32) { const int i = w >> 1; const float c = ((const float*)(p.ws + TAB_COSD))[t * 16 + i], sn = ((const float*)(p.ws + TAB_SIND))[t * 16 + i]; o = (w & 1) ? v * c + pv * sn : v * c - pv * sn; }
    s.base[(size_t)t * s.ld + s.cl] = (bf16_t)f2bf(o * s.scale);
}
DI void n_inproj(const Params& p) {
    const int lane = threadIdx.x & 63, gw = blockIdx.x * 8 + (threadIdx.x >> 6), NW = gridDim.x * 8, r = lane & 31, h = lane >> 5;
    const bf16_t* xb = (const bf16_t*)(p.ws + WS_XB); const bf16_t* wt = (const bf16_t*)(p.ws + WS_WIN);
    for (int T = gw; T < 256 * 256; T += NW) { const int tm = T / 256, tn = T % 256; f32x16 acc[2][2];
        sgemm64(acc, [&](int i) { return xb + (size_t)(tm * 64 + i) * DM; }, [&](int j) { return wt + (size_t)(tn * 64 + j) * DM; }, DM, lane);
#pragma unroll
        for (int mi = 0; mi < 2; ++mi)
#pragma unroll
            for (int ni = 0; ni < 2; ++ni)
#pragma unroll
                for (int q = 0; q < 16; ++q) { const float v = acc[mi][ni][q], pv = __shfl_xor(v, 1); inproj_store_elem(p, tm * 64 + mi * 32 + crow(q, h), tn * 64 + ni * 32 + r, v, pv); }
    }
}

template <int MODE>
DI void naive_attn_wave(const bf16_t* Q, const bf16_t* Kp, int ldqk, const bf16_t* V, bf16_t* O, int q0, float lg2gamma, LAS bf16_t* vl, int lane) {
    const int r = lane & 31, h = lane >> 5;
    bf16x8 qf[8];
#pragma unroll
    for (int ks = 0; ks < 8; ++ks) qf[ks] = *(const bf16x8*)(Q + (size_t)(q0 + r) * ldqk + ks * 16 + 8 * h);
    const int kend = ((q0 >> 6) + 1) << 6;
    constexpr float C2 = QK_SCALE * LOG2E;
    float m = -1e30f, l = 0.f, rl = 1.f;
    if (MODE == 1) {
        for (int kt = 0; kt < kend; kt += 32) {
            f32x16 st = {};
#pragma unroll
            for (int ks = 0; ks < 8; ++ks) { const bf16x8 kf = *(const bf16x8*)(Kp + (size_t)(kt + r) * ldqk + ks * 16 + 8 * h); st = MFMA32(kf, qf[ks], st); }
            float tm = st[0];
#pragma unroll
            for (int q = 1; q < 16; ++q) tm = fmaxf(tm, st[q]);
            tm = fmaxf(tm, __shfl_xor(tm, 32));
            const float mn = fmaxf(m, tm); float ps = 0.f;
#pragma unroll
            for (int q = 0; q < 16; ++q) ps += exp2f((st[q] - mn) * C2);
            ps += __shfl_xor(ps, 32);
            l = l * exp2f((m - mn) * C2) + ps; m = mn;
        }
        rl = 1.f / l;
    }
    f32x16 o[8];
#pragma unroll
    for (int cb = 0; cb < 8; ++cb)
#pragma unroll
        for (int q = 0; q < 16; ++q) o[cb][q] = 0.f;
    for (int kt = 0; kt < kend; kt += 32) {
        f32x16 st = {};
#pragma unroll
        for (int ks = 0; ks < 8; ++ks) { const bf16x8 kf = *(const bf16x8*)(Kp + (size_t)(kt + r) * ldqk + ks * 16 + 8 * h); st = MFMA32(kf, qf[ks], st); }
        float pr[16];
#pragma unroll
        for (int q = 0; q < 16; ++q) {
            if (MODE == 0) { const int d = (q0 + r) - (kt + crow(q, h)); pr[q] = st[q] * exp2f(lg2gamma * (float)(d < 0 ? -d : d)); }
            else pr[q] = exp2f((st[q] - m) * C2) * rl;
        }
        bf16x8 pa[2];
#pragma unroll
        for (int s = 0; s < 2; ++s) { u32x4 w = {pk2(pr[8 * s], pr[8 * s + 1]), pk2(pr[8 * s + 2], pr[8 * s + 3]), pk2(pr[8 * s + 4], pr[8 * s + 5]), pk2(pr[8 * s + 6], pr[8 * s + 7])}; pa[s] = __builtin_bit_cast(bf16x8, w); }
        asm volatile("s_waitcnt lgkmcnt(0)" ::: "memory");
#pragma unroll
        for (int i = 0; i < 16; ++i) { const int idx = i * 64 + lane, row = idx >> 5, ch = idx & 31; const u32x4 v = *(const u32x4*)(V + (size_t)(kt + row) * 2048 + ch * 8); *(LAS u32x4*)(vl + row * 256 + ch * 8) = v; }
        asm volatile("s_waitcnt vmcnt(0) lgkmcnt(0)" ::: "memory");
#pragma unroll
        for (int s = 0; s < 2; ++s)
#pragma unroll
            for (int cb = 0; cb < 8; ++cb) { bf16x8 vb;
#pragma unroll
                for (int j = 0; j < 8; ++j) vb[j] = (short)vl[crow(8 * s + j, h) * 256 + cb * 32 + r];
                o[cb] = MFMA32(pa[s], vb, o[cb]); }
    }
#pragma unroll
    for (int cb = 0; cb < 8; ++cb)
#pragma unroll
        for (int q = 0; q < 16; ++q) O[(size_t)(q0 + crow(q, h)) * 2048 + cb * 32 + r] = (bf16_t)f2bf(o[cb][q]);
}
DI void n_mixers(const Params& p, LAS unsigned char* lds) {
    const int lane = threadIdx.x & 63, wid = threadIdx.x >> 6, gw = blockIdx.x * 8 + wid, NW = gridDim.x * 8;
    LAS bf16_t* vl = (LAS bf16_t*)(lds + wid * 16384);
    unsigned char* ws = p.ws;
    for (int U = gw, it = 0; U < 4 * 8 * 128; U += NW, ++it) { int qb = U & 127; if (it & 1) qb = 127 - qb; const int bh = U >> 7, b = bh >> 3, h = bh & 7;
        const float gam = 1.f - exp2f(-5.f - (float)h); const float lg = log2f(gam);
        naive_attn_wave<0>((const bf16_t*)(ws + WS_RQ) + (size_t)b * SEQ * 2048 + h * 128, (const bf16_t*)(ws + WS_RQ) + (size_t)b * SEQ * 2048 + 1024 + h * 128, 2048,
                           (const bf16_t*)(ws + WS_RV) + (size_t)b * SEQ * 2048 + h * 256, (bf16_t*)p.out + (size_t)b * SEQ * 2048 + h * 256, qb * 32, lg, vl, lane); }
    for (int U = gw, it = 0; U < 4 * 8 * 2 * 128; U += NW, ++it) { int qb = U & 127; if (it & 1) qb = 127 - qb; const int bhi = U >> 7, i = bhi & 1, h = (bhi >> 1) & 7, b = bhi >> 4;
        naive_attn_wave<1>((const bf16_t*)(ws + WS_DQ) + (size_t)b * SEQ * 2048 + h * 256 + i * 128, (const bf16_t*)(ws + WS_DK) + (size_t)b * SEQ * 2048 + h * 256 + i * 128, 2048,
                           (const bf16_t*)(ws + WS_DV) + (size_t)b * SEQ * 2048 + h * 256, (bf16_t*)(ws + (i ? WS_O1 : WS_O0)) + (size_t)b * SEQ * 2048 + h * 256, qb * 32, 0.f, vl, lane); }
}

DI float half_sum(float v) {
#define WS_DPP(ctrl) v += __int_as_float(__builtin_amdgcn_update_dpp(0, __float_as_int(v), (ctrl), 0xf, 0xf, true))
    WS_DPP(0xB1); WS_DPP(0x4E); WS_DPP(0x141); WS_DPP(0x140);
#undef WS_DPP
    { auto r16_ = __builtin_amdgcn_permlane16_swap(__float_as_uint(v), __float_as_uint(v), false, false); return __uint_as_float(r16_[0]) + __uint_as_float(r16_[1]); }
}
DI void phase_norms(const Params& p) {
    const int lane = threadIdx.x & 63, gw = blockIdx.x * 8 + (threadIdx.x >> 6), NW = gridDim.x * 8;
    unsigned char* ws = p.ws; const float lam = ((const float*)(ws + TAB_MISC))[0];
    const bf16_t* rr = (const bf16_t*)p.out; const bf16_t* rg = (const bf16_t*)(ws + WS_RG); const bf16_t* o0 = (const bf16_t*)(ws + WS_O0); const bf16_t* o1 = (const bf16_t*)(ws + WS_O1);
    bf16_t* retA = (bf16_t*)p.out; bf16_t* diffA = (bf16_t*)(ws + WS_DIFFA);
    const int e0 = (lane & 31) * 8;
    f32x4 sgl = *(const f32x4*)(p.subln + e0), sgh = *(const f32x4*)(p.subln + e0 + 4);
    for (int t = gw; t < NTOK; t += NW) {
        u32x4 wr_[4], wg_[4], wa_[4], wb_[4];
#pragma unroll
        for (int j = 0; j < 4; ++j) { const size_t off = (size_t)t * DM + j * 512 + lane * 8; wr_[j] = *(const u32x4*)(rr + off); wg_[j] = *(const u32x4*)(rg + off); wa_[j] = *(const u32x4*)(o0 + off); wb_[j] = *(const u32x4*)(o1 + off); }
#pragma unroll
        for (int j = 0; j < 4; ++j) { const size_t off = (size_t)t * DM + j * 512 + lane * 8; const int c = j * 512 + lane * 8;
            float v[8], g[8], a[8], bb[8], y[8];
            unpack8(wr_[j], v); unpack8(wg_[j], g); unpack8(wa_[j], a); unpack8(wb_[j], bb);
            float s = 0.f;
#pragma unroll
            for (int k = 0; k < 8; ++k) s += v[k];
            const float mean = half_sum(s) * (1.f / 256.f); float q = 0.f;
#pragma unroll
            for (int k = 0; k < 8; ++k) { v[k] -= mean; q += v[k] * v[k]; }
            const float rstd = rsqrtf(half_sum(q) * (1.f / 256.f) + LN_EPS);
            const f32x4 gl = *(const f32x4*)(p.ret_gn + c), gh = *(const f32x4*)(p.ret_gn + c + 4);
#pragma unroll
            for (int k = 0; k < 8; ++k) y[k] = v[k] * rstd * (k < 4 ? gl[k & 3] : gh[k & 3]) * (g[k] * sigmoidf_(g[k]));
            *(u32x4*)(retA + off) = (u32x4){pk2(y[0], y[1]), pk2(y[2], y[3]), pk2(y[4], y[5]), pk2(y[6], y[7])};
            float d[8], ms = 0.f;
#pragma unroll
            for (int k = 0; k < 8; ++k) { d[k] = a[k] - lam * bb[k]; ms += d[k] * d[k]; }
            const float rs = rsqrtf(half_sum(ms) * (1.f / 256.f) + LN_EPS) * (1.f - LAMBDA_INIT);
#pragma unroll
            for (int k = 0; k < 8; ++k) y[k] = d[k] * rs * (k < 4 ? sgl[k & 3] : sgh[k & 3]);
            *(u32x4*)(diffA + off) = (u32x4){pk2(y[0], y[1]), pk2(y[2], y[3]), pk2(y[4], y[5]), pk2(y[6], y[7])}; }
    }
}

DI void n_proj(const Params& p) {
    const int lane = threadIdx.x & 63, gw = blockIdx.x * 8 + (threadIdx.x >> 6), NW = gridDim.x * 8, r = lane & 31, h = lane >> 5;
    unsigned char* ws = p.ws; const bf16_t* gates = (const bf16_t*)(ws + WS_GATES); bf16_t* merged = (bf16_t*)(ws + WS_MERGED);
    for (int T = gw; T < 256 * 32; T += NW) { const int tm = T / 32, tn = T % 32; f32x16 a1[2][2], a2[2][2];
        sgemm64(a1, [&](int i) { return (const bf16_t*)p.out + (size_t)(tm * 64 + i) * DM; }, [&](int j) { return (const bf16_t*)(ws + WS_WR) + (size_t)(tn * 64 + j) * DM; }, DM, lane);
        sgemm64(a2, [&](int i) { return (const bf16_t*)(ws + WS_DIFFA) + (size_t)(tm * 64 + i) * DM; }, [&](int j) { return (const bf16_t*)(ws + WS_WD) + (size_t)(tn * 64 + j) * DM; }, DM, lane);
#pragma unroll
        for (int mi = 0; mi < 2; ++mi)
#pragma unroll
            for (int ni = 0; ni < 2; ++ni)
#pragma unroll
                for (int q = 0; q < 16; ++q) { const int t = tm * 64 + mi * 32 + crow(q, h), c = tn * 64 + ni * 32 + r;
                    const float gr = bf2f(gates[(size_t)t * 4096 + c]), gd = bf2f(gates[(size_t)t * 4096 + 2048 + c]);
                    const float t1 = bf2f(f2bf(sigmoidf_(gr) * a1[mi][ni][q]));
                    merged[(size_t)t * DM + c] = (bf16_t)f2bf(t1 + sigmoidf_(gd) * a2[mi][ni][q]); }
    }
}
DI void n_outproj(const Params& p) {
    const int lane = threadIdx.x & 63, gw = blockIdx.x * 8 + (threadIdx.x >> 6), NW = gridDim.x * 8, r = lane & 31, h = lane >> 5;
    unsigned char* ws = p.ws;
    for (int T = gw; T < 256 * 32; T += NW) { const int tm = T / 32, tn = T % 32; f32x16 a[2][2];
        sgemm64(a, [&](int i) { return (const bf16_t*)(ws + WS_MERGED) + (size_t)(tm * 64 + i) * DM; }, [&](int j) { return (const bf16_t*)(ws + WS_WO) + (size_t)(tn * 64 + j) * DM; }, DM, lane);
#pragma unroll
        for (int mi = 0; mi < 2; ++mi)
#pragma unroll
            for (int ni = 0; ni < 2; ++ni)
#pragma unroll
                for (int q = 0; q < 16; ++q) { const size_t o = (size_t)(tm * 64 + mi * 32 + crow(q, h)) * DM + tn * 64 + ni * 32 + r; p.out[o] = ALPHA * p.x[o] + a[mi][ni][q]; }
    }
}

DI void phase_ln1_router(const Params& p) {
    const int lane = threadIdx.x & 63, gw = blockIdx.x * 8 + (threadIdx.x >> 6), NW = gridDim.x * 8;
    unsigned char* ws = p.ws; bf16_t* hb = (bf16_t*)(ws + WS_HB); const float* wrt = (const float*)(ws + RT_WRT);
    int* cnt = (int*)(ws + RT_CNT); int* stok = (int*)(ws + RT_SLOTTOK); float* sw = (float*)(ws + RT_SLOTW); int* sdst = (int*)(ws + RT_SLOTDST);
    for (int t0 = gw * 4; t0 < NTOK; t0 += NW * 4) {
        f32x4 v[4][8];
#pragma unroll
        for (int q = 0; q < 4; ++q) { const float* row = p.x + (size_t)(t0 + q) * DM; const bf16_t* mrow = (const bf16_t*)p.out + (size_t)(t0 + q) * DM; float s = 0.f;
#pragma unroll
            for (int j = 0; j < 8; ++j) { const f32x4 xv = __builtin_nontemporal_load((const f32x4*)(row + j * 256 + lane * 4)); const u32x2 mw = __builtin_nontemporal_load((const u32x2*)(mrow + j * 256 + lane * 4));
                v[q][j] = xv * ALPHA + (f32x4){bf2f(mw.x & 0xffff), bf2f(mw.x >> 16), bf2f(mw.y & 0xffff), bf2f(mw.y >> 16)}; s += (v[q][j][0] + v[q][j][1]) + (v[q][j][2] + v[q][j][3]); }
            const float mean = wave_sum(s) * (1.f / DM); float qq = 0.f;
#pragma unroll
            for (int j = 0; j < 8; ++j) { v[q][j] = v[q][j] - mean; qq += (v[q][j][0] * v[q][j][0] + v[q][j][1] * v[q][j][1]) + (v[q][j][2] * v[q][j][2] + v[q][j][3] * v[q][j][3]); }
            const float rstd = rsqrtf(wave_sum(qq) * (1.f / DM) + LN_EPS);
#pragma unroll
            for (int j = 0; j < 8; ++j) { const f32x4 g = *(const f32x4*)(p.ln1g + j * 256 + lane * 4), bb = *(const f32x4*)(p.ln1b + j * 256 + lane * 4);
                v[q][j] = v[q][j] * rstd * g + bb;
                *(u32x2*)(hb + (size_t)(t0 + q) * DM + j * 256 + lane * 4) = (u32x2){pk2(v[q][j][0], v[q][j][1]), pk2(v[q][j][2], v[q][j][3])};
                *(unsigned*)(ws + WS_HB8 + (size_t)(t0 + q) * DM + j * 256 + lane * 4) = pk4_fp8(v[q][j][0] * F8_SX, v[q][j][1] * F8_SX, v[q][j][2] * F8_SX, v[q][j][3] * F8_SX); } }
        float logit[4] = {0.f, 0.f, 0.f, 0.f};
        for (int e = 0; e < 36; ++e) { f32x4 w[8]; float a[4] = {0.f, 0.f, 0.f, 0.f};
#pragma unroll
            for (int j = 0; j < 8; ++j) w[j] = *(const f32x4*)(wrt + (size_t)e * DM + j * 256 + lane * 4);
#pragma unroll
            for (int q = 0; q < 4; ++q) {
#pragma unroll
                for (int j = 0; j < 8; ++j) a[q] += (v[q][j][0] * w[j][0] + v[q][j][1] * w[j][1]) + (v[q][j][2] * w[j][2] + v[q][j][3] * w[j][3]);
                a[q] = wave_sum(a[q]) + wrt[36 * DM + e]; if (lane == e) logit[q] = a[q]; } }
        int sel_e = 0; float sel_w = 0.f;
#pragma unroll
        for (int q = 0; q < 4; ++q) { const float mylogit = logit[q];
            float gl[4];
#pragma unroll
            for (int g = 0; g < 4; ++g) gl[g] = __int_as_float(__builtin_amdgcn_readlane(__float_as_int(mylogit), g));
            int gs = 0; float gm = gl[0];
#pragma unroll
            for (int g = 1; g < 4; ++g) if (gl[g] > gm) { gm = gl[g]; gs = g; }
            float den = 0.f;
#pragma unroll
            for (int g = 0; g < 4; ++g) den += __expf(gl[g] - gm);
            const float pg = 1.f / den;
            float wv[8];
            const int gsu = __builtin_amdgcn_readfirstlane(gs);
#pragma unroll
            for (int i = 0; i < 8; ++i) wv[i] = __int_as_float(__builtin_amdgcn_readlane(__float_as_int(mylogit), 4 + gsu * 8 + i));
            int i1 = 0; float v1 = wv[0];
#pragma unroll
            for (int i = 1; i < 8; ++i) if (wv[i] > v1) { v1 = wv[i]; i1 = i; }
            int i2 = -1; float v2 = -3.0e38f;
#pragma unroll
            for (int i = 0; i < 8; ++i) if (i != i1 && wv[i] > v2) { v2 = wv[i]; i2 = i; }
            const float e2 = __expf(v2 - v1), w1 = pg / (1.f + e2), w2 = pg * e2 / (1.f + e2);
            if (lane == 2 * q) { sel_e = gs * 8 + i1; sel_w = w1; }
            if (lane == 2 * q + 1) { sel_e = gs * 8 + i2; sel_w = w2; } }
        if (lane < 8) { const int t = t0 + (lane >> 1), k = lane & 1; const int pos = atomicAdd(cnt + sel_e, 1);
            stok[sel_e * NTOK + pos] = t; ((int*)(ws + RT_TOKE))[t * 2 + k] = sel_e * NTOK + pos; ((float*)(ws + RT_TOKW))[t * 2 + k] = sel_w; }
    }
}
DI void phase_slots(const Params& p, LAS unsigned char* lds) {
    unsigned char* ws = p.ws; const int* tok_e = (const int*)(ws + RT_TOKE); const float* tok_w = (const float*)(ws + RT_TOKW);
    LAS int* wsum = (LAS int*)lds;
    const int tid = threadIdx.x, lane = tid & 63, wid = tid >> 6;
    for (int e = blockIdx.x; e < NEXP; e += gridDim.x) {
        int* st = (int*)(ws + RT_SLOTTOK) + e * NTOK; float* sw = (float*)(ws + RT_SLOTW) + e * NTOK; int* sd = (int*)(ws + RT_SLOTDST) + e * NTOK;
        int base = 0;
        for (int it = 0; it < (2 * NTOK) / 512; ++it) { const int a = it * 512 + tid; const bool f = tok_e[a] == e;
            const unsigned long long bal = __ballot(f); const int pre = __popcll(bal & ((1ull << lane) - 1ull)), tot = __popcll(bal);
            if (lane == 0) wsum[wid] = tot;
            __syncthreads();
            int woff = 0, all = 0;
#pragma unroll
            for (int w = 0; w < 8; ++w) { const int c = wsum[w]; if (w < wid) woff += c; all += c; }
            if (f) { const int pos = base + woff + pre; st[pos] = a >> 1; sw[pos] = tok_w[a]; sd[pos] = a; }
            base += all;
            __syncthreads(); }
        if (tid == 0) ((int*)(ws + RT_CNT))[e] = base;
    }
}
DI void n_moe_up(const Params& p) {
    const int lane = threadIdx.x & 63, gw = blockIdx.x * 8 + (threadIdx.x >> 6), NW = gridDim.x * 8, r = lane & 31, h = lane >> 5;
    unsigned char* ws = p.ws; const int* cnt = (const int*)(ws + RT_CNT); const bf16_t* hb = (const bf16_t*)(ws + WS_HB); bf16_t* act = (bf16_t*)(ws + WS_ACT);
    int idx = gw, base = 0;
    for (int e = 0; e < NEXP; ++e) { const int c = cnt[e], mt = (c + 63) >> 6, ne = mt * 32; const int* st = (const int*)(ws + RT_SLOTTOK) + e * NTOK;
        const bf16_t* W = (const bf16_t*)(ws + WS_WGU) + (size_t)e * 2048 * DM;
        while (idx < ne) { const int m = idx >> 5, f = idx & 31; f32x16 a[2][2];
            sgemm64(a, [&](int i) { int s = m * 64 + i; if (s > c - 1) s = c - 1; return hb + (size_t)st[s] * DM; },
                       [&](int j) { const int ff = f * 32 + (j & 31); return W + (size_t)((ff >> 7) * 256 + (ff & 127) + (j >= 32 ? 128 : 0)) * DM; }, DM, lane);
#pragma unroll
            for (int mi = 0; mi < 2; ++mi)
#pragma unroll
                for (int q = 0; q < 16; ++q) { const int s = m * 64 + mi * 32 + crow(q, h); if (s < c) { const float g = a[mi][0][q], u = a[mi][1][q]; act[(size_t)(base + s) * FF + f * 32 + r] = (bf16_t)f2bf(g * sigmoidf_(g) * u); } }
            idx += NW; }
        idx -= ne; base += (c + 255) & ~255; }
}
DI void n_moe_down(const Params& p) {
    const int lane = threadIdx.x & 63, gw = blockIdx.x * 8 + (threadIdx.x >> 6), NW = gridDim.x * 8, r = lane & 31, h = lane >> 5;
    unsigned char* ws = p.ws; const int* cnt = (const int*)(ws + RT_CNT); const bf16_t* act = (const bf16_t*)(ws + WS_ACT); bf16_t* yk = (bf16_t*)(ws + WS_YK);
    int idx = gw, base = 0;
    for (int e = 0; e < NEXP; ++e) { const int c = cnt[e], mt = (c + 63) >> 6, ne = mt * 32; const int* sd = (const int*)(ws + RT_SLOTDST) + e * NTOK; const float* sw = (const float*)(ws + RT_SLOTW) + e * NTOK;
        const bf16_t* W = (const bf16_t*)(ws + WS_WDN) + (size_t)e * DM * FF;
        while (idx < ne) { const int m = idx >> 5, cn = idx & 31; f32x16 a[2][2];
            sgemm64(a, [&](int i) { int s = m * 64 + i; if (s > c - 1) s = c - 1; return act + (size_t)(base + s) * FF; }, [&](int j) { return W + (size_t)(cn * 64 + j) * FF; }, FF, lane);
#pragma unroll
            for (int mi = 0; mi < 2; ++mi)
#pragma unroll
                for (int q = 0; q < 16; ++q) { const int s = m * 64 + mi * 32 + crow(q, h); if (s < c) { const int d = sd[s]; const float w = sw[s];
#pragma unroll
                    for (int ni = 0; ni < 2; ++ni) yk[(size_t)(d & 1) * NTOK * DM + (size_t)(d >> 1) * DM + cn * 64 + ni * 32 + r] = (bf16_t)f2bf(w * a[mi][ni][q]); } }
            idx += NW; }
        idx -= ne; base += (c + 255) & ~255; }
}
DI void phase_final(const Params& p) {
    const int lane = threadIdx.x & 63, gw = blockIdx.x * 8 + (threadIdx.x >> 6), NW = gridDim.x * 8;
    const bf16_t* ykc = (const bf16_t*)(p.ws + WS_YKC); const bf16_t* hbp = (const bf16_t*)(p.ws + WS_HB);
    const int* tslot = (const int*)(p.ws + RT_TOKE); const float* tw = (const float*)(p.ws + RT_TOKW); const int* cnt = (const int*)(p.ws + RT_CNT);
    int mybase = 0; { const int e = lane & 31; for (int q = 0; q < e; ++q) mybase += (cnt[q] + 255) & ~255; }
    for (int t = gw; t < NTOK; t += NW) {
        const int s0 = tslot[t * 2], s1 = tslot[t * 2 + 1]; const float w0 = tw[t * 2], w1 = tw[t * 2 + 1];
        const int e0_ = __builtin_amdgcn_readfirstlane(s0 >> 14), e1_ = __builtin_amdgcn_readfirstlane(s1 >> 14);
        const size_t r0 = (size_t)(__builtin_amdgcn_readlane(mybase, e0_) + (s0 & (NTOK - 1))), r1 = (size_t)(__builtin_amdgcn_readlane(mybase, e1_) + (s1 & (NTOK - 1)));
        float* row = p.out + (size_t)t * DM; float v[4][8]; float s = 0.f;
        u32x4 hw[4], aw[4], bw[4];
#pragma unroll
        for (int j = 0; j < 4; ++j) { const size_t c = j * 512 + lane * 8; hw[j] = __builtin_nontemporal_load((const u32x4*)(hbp + (size_t)t * DM + c)); aw[j] = __builtin_nontemporal_load((const u32x4*)(ykc + r0 * DM + c)); bw[j] = __builtin_nontemporal_load((const u32x4*)(ykc + r1 * DM + c)); }
#pragma unroll
        for (int j = 0; j < 4; ++j) { float hv[8], a[8], b[8]; unpack8(hw[j], hv); unpack8(aw[j], a); unpack8(bw[j], b);
#pragma unroll
            for (int k = 0; k < 8; ++k) { v[j][k] = ALPHA * hv[k] + (w0 * a[k] + w1 * b[k]); s += v[j][k]; } }
        const float mean = wave_sum(s) * (1.f / DM); float q = 0.f;
#pragma unroll
        for (int j = 0; j < 4; ++j)
#pragma unroll
            for (int k = 0; k < 8; ++k) { v[j][k] -= mean; q += v[j][k] * v[j][k]; }
        const float rstd = rsqrtf(wave_sum(q) * (1.f / DM) + LN_EPS);
#pragma unroll
        for (int j = 0; j < 4; ++j) { const int c = j * 512 + lane * 8; const f32x4 g0 = *(const f32x4*)(p.ln2g + c), g1 = *(const f32x4*)(p.ln2g + c + 4), b0 = *(const f32x4*)(p.ln2b + c), b1 = *(const f32x4*)(p.ln2b + c + 4);
            *(f32x4*)(row + c) = (f32x4){v[j][0] * rstd * g0[0] + b0[0], v[j][1] * rstd * g0[1] + b0[1], v[j][2] * rstd * g0[2] + b0[2], v[j][3] * rstd * g0[3] + b0[3]};
            *(f32x4*)(row + c + 4) = (f32x4){v[j][4] * rstd * g1[0] + b1[0], v[j][5] * rstd * g1[1] + b1[1], v[j][6] * rstd * g1[2] + b1[2], v[j][7] * rstd * g1[3] + b1[3]}; }
    }
}

namespace pg8 {
constexpr int BM = 256, BK = 64, HALF = 128, HTB = HALF * BK * 2  , STAGE_BYTES = 8 * HTB, NXCD = 8, WGM = 8;
DI int lds_byte(int r, int c) { const int st = (r >> 4) * 2 + (c >> 5), rr = r & 15, cc = c & 31, ob = rr * 64 + cc * 2; return st * 1024 + (ob ^ (((ob >> 9) & 1) << 5)); }
DI void stage_rc(int b, int& R, int& C) { const int st = b / 1024, sb = b % 1024, swz = sb ^ (((sb >> 9) & 1) << 5); R = (st >> 1) * 16 + swz / 64; C = (st & 1) * 32 + (swz % 64) / 2; }
DI int perm32(int rho) { const int n = rho >> 4, i = rho & 15; return 8 * (i >> 2) + 4 * n + (i & 3); }

struct Unit { const char* A; const char* B; int pm, pn, e, rows, rowbase, slot0; };

struct StaticOrder {
    static constexpr bool GATHER = false;
    const char* A; const char* Bt; int K; int nM, nN, nwg, G, c; int split = 1 << 30, off0 = 0, off1 = 0;
    DI void init(const bf16_t* A_, const bf16_t* Bt_, int M, int N, int K_, int G_, int c_) { A = (const char*)A_; Bt = (const char*)Bt_; K = K_; nM = M / BM; nN = N / BM; nwg = nM * nN; G = G_; c = c_; }
    DI bool next(int i, Unit& u) const {
        const long L = (long)i * G + c; if (L >= nwg) return false;
        int wgid = (int)L; { const int q = nwg / NXCD, r = nwg % NXCD, xcd = wgid % NXCD, off = wgid / NXCD; wgid = (xcd < r ? xcd * (q + 1) : r * (q + 1) + (xcd - r) * q) + off; }
        const int nig = WGM * nN, gid = wgid / nig, fm = gid * WGM, gsz = (nM - fm) < WGM ? (nM - fm) : WGM;
        u.pm = fm + ((wgid % nig) % gsz); u.pn = (wgid % nig) / gsz; u.pn += u.pn < split ? off0 : off1;
        u.A = A + (size_t)u.pm * BM * K * 2; u.B = Bt + (size_t)u.pn * BM * K * 2; u.e = 0; u.rows = BM; u.rowbase = u.pm * BM; u.slot0 = 0; return true;
    }
    DI unsigned goff(const Unit&, int, unsigned) const { return 0u; }
};

DI unsigned cvt_pk_bf16(float lo, float hi) { unsigned r; asm volatile("v_cvt_pk_bf16_f32 %0, %1, %2" : "=v"(r) : "v"(lo), "v"(hi)); return r; }

template <class Epi, class Sched, bool ALIGN_EPI = false, bool SP2 = false>
DI void gemm_phase(LAS unsigned char* lds, const int K, const Sched& S, const Epi& E) {
    constexpr bool GATHER = Sched::GATHER;
    int tid_ = threadIdx.x; asm volatile("" : "+v"(tid_));
    const int tid = tid_, wid = __builtin_amdgcn_readfirstlane(tid >> 6), lane = tid & 63, wr = wid >> 2, wc = wid & 3, fr = lane & 15, fq = lane >> 4;
    const int nt = K / BK;
    unsigned voffA[2], voffB[2]; unsigned gpk[2];
#pragma unroll
    for (int i = 0; i < 2; ++i) { int R, C; stage_rc(tid * 16 + i * 8192, R, C); const int Rb = Epi::PERM ? ((R & ~31) + perm32(R & 31)) : R;
        voffA[i] = (unsigned)(R * K + C) * 2u; voffB[i] = (unsigned)(Rb * K + C) * 2u; gpk[i] = ((unsigned)R << 8) | (unsigned)C; }
    const size_t kstep = (size_t)(BK * 2);
    const size_t hstep = (size_t)HALF * K * 2;
    const unsigned ldsw = (unsigned)wid * 1024u;
    const int aoff = lds_byte(wr * 64 + fr, fq * 8), boff = lds_byte(wc * 32 + fr, fq * 8);
#define PG8_SA(b, h) (((b) * 2 + (h)) * HTB)
#define PG8_SB(b, h) ((4 + (b) * 2 + (h)) * HTB)
#define PG8_STAGE(bufoff, gbase, voff) do { _Pragma("unroll") for (int _i = 0; _i < 2; ++_i) \
        __builtin_amdgcn_global_load_lds((const unsigned*)((const char*)(gbase) + (voff)[_i]), (LAS unsigned*)(lds + (bufoff) + ldsw + _i * 8192), 16, 0, 0); } while (0)
#define PG8_STAGE_A(bufoff, NX, hh, kb) do { if constexpr (GATHER) { _Pragma("unroll") for (int _i = 0; _i < 2; ++_i) \
        __builtin_amdgcn_global_load_lds((const unsigned*)(gA + S.goff((NX) ? nxt : cur, hh, gpk[_i]) + (kb)), (LAS unsigned*)(lds + (bufoff) + ldsw + _i * 8192), 16, 0, 0); } \
        else { PG8_STAGE(bufoff, ((NX) ? nA : cA) + (hh) * hstep + (kb), voffA); } } while (0)
    typedef int i32x4_ __attribute__((ext_vector_type(4))); typedef int i32x8_ __attribute__((ext_vector_type(8)));
#define PG8_LDA(dst, b, h) do { _Pragma("unroll") for (int m = 0; m < 4; ++m) { if constexpr (Epi::FP8) dst##8[m] = __builtin_shufflevector(*(const LAS i32x4_*)(lds + PG8_SA(b, h) + aoff + m * 2048), *(const LAS i32x4_*)(lds + PG8_SA(b, h) + aoff + m * 2048 + 1024), 0, 1, 2, 3, 4, 5, 6, 7); \
        else { _Pragma("unroll") for (int k = 0; k < 2; ++k) dst[m][k] = *(const LAS bf16x8*)(lds + PG8_SA(b, h) + aoff + m * 2048 + k * 1024); } } } while (0)
#define PG8_LDB(dst, b, h) do { _Pragma("unroll") for (int n = 0; n < 2; ++n) { if constexpr (Epi::FP8) dst##8[n] = __builtin_shufflevector(*(const LAS i32x4_*)(lds + PG8_SB(b, h) + boff + n * 2048), *(const LAS i32x4_*)(lds + PG8_SB(b, h) + boff + n * 2048 + 1024), 0, 1, 2, 3, 4, 5, 6, 7); \
        else { _Pragma("unroll") for (int k = 0; k < 2; ++k) dst[n][k] = *(const LAS bf16x8*)(lds + PG8_SB(b, h) + boff + n * 2048 + k * 1024); } } } while (0)
#define PG8_MMA(ai, bj, At, Bt) do { __builtin_amdgcn_s_setprio(1); _Pragma("unroll") for (int m = 0; m < 4; ++m) _Pragma("unroll") for (int n = 0; n < 2; ++n) { \
        if constexpr (Epi::FP8) { asm volatile("v_mfma_scale_f32_16x16x128_f8f6f4 %0, %1, %2, %0, %3, %4 op_sel_hi:[0,0,0]" : "+v"(acc[ai][bj][m][n]) : "v"(Bt##8[n]), "v"(At##8[m]), "v"(f8sw), "v"(f8sx)); } \
        else { _Pragma("unroll") for (int k = 0; k < 2; ++k) acc[ai][bj][m][n] = __builtin_amdgcn_mfma_f32_16x16x32_bf16(Bt[n][k], At[m][k], acc[ai][bj][m][n], 0, 0, 0); } } \
        __builtin_amdgcn_s_setprio(0); } while (0)
#define PG8_WAIT_V(n) asm volatile("s_waitcnt vmcnt(" #n ")" ::: "memory")
#define PG8_WAIT_L(n) asm volatile("s_waitcnt lgkmcnt(" #n ")" ::: "memory")
#define PG8_BAR __builtin_amdgcn_s_barrier()
#define PG8_SCHED __builtin_amdgcn_sched_barrier(0)
    Unit cur, nxt; int ui = 0;
    if (!S.next(0, cur)) return;
    f32x4 acc[2][2][4][2];
#pragma unroll
    for (int a = 0; a < 2; ++a)
#pragma unroll
        for (int b = 0; b < 2; ++b)
#pragma unroll
            for (int m = 0; m < 4; ++m)
#pragma unroll
                for (int n = 0; n < 2; ++n) acc[a][b][m][n] = (f32x4){0.f, 0.f, 0.f, 0.f};
    bf16x8 At[4][2], B0[2][2], B1[2][2]; i32x8_ At8[4], B08[2], B18[2];
    int f8sw = Epi::SCALE_W, f8sx = Epi::SCALE_X; asm volatile("" : "+v"(f8sw), "+v"(f8sx));
    const char* cA = cur.A; const char* cB = cur.B; const char* nA = cA; const char* nB = cB;
    const char* gA = nullptr;
    if constexpr (GATHER) { gA = S.gbase; }
    if constexpr (SP2) {
        PG8_STAGE(PG8_SB(0, 0), cB, voffB); PG8_STAGE(PG8_SB(0, 1), cB + hstep, voffB); PG8_STAGE_A(PG8_SA(0, 0), false, 0, 0); PG8_STAGE_A(PG8_SA(0, 1), false, 1, 0);
        if (wr == 1) PG8_BAR;
        PG8_WAIT_V(2); PG8_BAR;
        PG8_STAGE(PG8_SB(1, 0), cB + kstep, voffB); PG8_STAGE_A(PG8_SA(1, 0), false, 0, kstep); PG8_STAGE(PG8_SB(1, 1), cB + hstep + kstep, voffB);
        PG8_WAIT_V(6); PG8_BAR;
    } else {
        PG8_STAGE(PG8_SB(0, 0), cB, voffB); PG8_STAGE_A(PG8_SA(0, 0), false, 0, 0); PG8_STAGE(PG8_SB(0, 1), cB + hstep, voffB); PG8_STAGE_A(PG8_SA(0, 1), false, 1, 0);
        if (wr == 1) PG8_BAR;
        PG8_WAIT_V(4); PG8_BAR;
        PG8_STAGE(PG8_SB(1, 0), cB + kstep, voffB); PG8_STAGE_A(PG8_SA(1, 0), false, 0, kstep); PG8_STAGE(PG8_SB(1, 1), cB + hstep + kstep, voffB);
        PG8_WAIT_V(6); PG8_BAR;
    }
    for (;;) {
        const bool has_next = S.next(ui + 1, nxt);
        nA = has_next ? nxt.A : cA; nB = has_next ? nxt.B : cB;
        if (!has_next) nxt = cur;
#pragma unroll 1
        for (int t = 0; t < nt; t += 2) {
            const bool last = (t == nt - 2);
            const size_t k1 = (size_t)(t + 1) * kstep;
            const size_t k2 = last ? 0 : (size_t)(t + 2) * kstep, k3 = k2 + kstep;
            const char* b2 = last ? nB : cB + k2; const char* b3 = b2 + kstep;
            if constexpr (SP2) {
            PG8_LDB(B0, 0, 0); PG8_LDB(B1, 0, 1); PG8_SCHED; PG8_LDA(At, 0, 0); PG8_STAGE_A(PG8_SA(1, 1), false, 1, k1);
            PG8_WAIT_V(8); PG8_WAIT_L(0); PG8_BAR; PG8_MMA(0, 0, At, B0); PG8_MMA(0, 1, At, B1); PG8_BAR; PG8_SCHED;
            PG8_LDA(At, 0, 1); PG8_STAGE(PG8_SB(0, 0), b2, voffB); PG8_STAGE(PG8_SB(0, 1), b2 + hstep, voffB); if (last) PG8_STAGE_A(PG8_SA(0, 0), true, 0, k2); else PG8_STAGE_A(PG8_SA(0, 0), false, 0, k2);
            PG8_WAIT_V(8); PG8_WAIT_L(0); PG8_BAR; PG8_MMA(1, 0, At, B0); PG8_MMA(1, 1, At, B1); PG8_BAR; PG8_SCHED;
            PG8_LDB(B0, 1, 0); PG8_LDB(B1, 1, 1); PG8_SCHED; PG8_LDA(At, 1, 0); if (last) PG8_STAGE_A(PG8_SA(0, 1), true, 1, k2); else PG8_STAGE_A(PG8_SA(0, 1), false, 1, k2);
            PG8_WAIT_V(8); PG8_WAIT_L(0); PG8_BAR; PG8_MMA(0, 0, At, B0); PG8_MMA(0, 1, At, B1); PG8_BAR; PG8_SCHED;
            PG8_LDA(At, 1, 1); PG8_STAGE(PG8_SB(1, 0), b3, voffB); PG8_STAGE(PG8_SB(1, 1), b3 + hstep, voffB); if (last) PG8_STAGE_A(PG8_SA(1, 0), true, 0, k3); else PG8_STAGE_A(PG8_SA(1, 0), false, 0, k3);
            PG8_WAIT_V(8); PG8_WAIT_L(0); PG8_BAR; PG8_MMA(1, 0, At, B0); PG8_MMA(1, 1, At, B1); PG8_BAR; PG8_SCHED;
            } else {
            PG8_LDB(B0, 0, 0); PG8_SCHED; PG8_LDA(At, 0, 0); PG8_STAGE_A(PG8_SA(1, 1), false, 1, k1);
            PG8_WAIT_L(8); PG8_BAR; PG8_WAIT_L(0); PG8_MMA(0, 0, At, B0); PG8_BAR; PG8_SCHED;
            PG8_LDB(B1, 0, 1); PG8_STAGE(PG8_SB(0, 0), b2, voffB);
            PG8_BAR; PG8_WAIT_L(0); PG8_MMA(0, 1, At, B1); PG8_BAR;
            PG8_LDA(At, 0, 1); if (last) PG8_STAGE_A(PG8_SA(0, 0), true, 0, k2); else PG8_STAGE_A(PG8_SA(0, 0), false, 0, k2);
            PG8_BAR; PG8_WAIT_L(0); PG8_MMA(1, 0, At, B0); PG8_BAR; PG8_SCHED;
            PG8_STAGE(PG8_SB(0, 1), b2 + hstep, voffB);
            PG8_WAIT_V(6); PG8_BAR; PG8_MMA(1, 1, At, B1); PG8_BAR;
            PG8_LDB(B0, 1, 0); PG8_SCHED; PG8_LDA(At, 1, 0); if (last) PG8_STAGE_A(PG8_SA(0, 1), true, 1, k2); else PG8_STAGE_A(PG8_SA(0, 1), false, 1, k2);
            PG8_WAIT_L(8); PG8_BAR; PG8_WAIT_L(0); PG8_MMA(0, 0, At, B0); PG8_BAR; PG8_SCHED;
            PG8_LDB(B1, 1, 1); PG8_STAGE(PG8_SB(1, 0), b3, voffB);
            PG8_BAR; PG8_WAIT_L(0); PG8_MMA(0, 1, At, B1); PG8_BAR;
            PG8_LDA(At, 1, 1); if (last) PG8_STAGE_A(PG8_SA(1, 0), true, 0, k3); else PG8_STAGE_A(PG8_SA(1, 0), false, 0, k3);
            PG8_BAR; PG8_WAIT_L(0); PG8_MMA(1, 0, At, B0); PG8_BAR; PG8_SCHED;
            PG8_STAGE(PG8_SB(1, 1), b3 + hstep, voffB);
            PG8_WAIT_V(6); PG8_BAR; PG8_MMA(1, 1, At, B1); PG8_BAR;
            }
        }
        if constexpr (ALIGN_EPI) { if (wr == 0) PG8_BAR; }
        if constexpr (Epi::FP8) asm volatile("s_nop 15\n\ts_nop 15" ::: "memory");
        if constexpr (Epi::PAIRED) { if (cur.e == 0) E.mid(acc, cur, wr, wc, fr, fq); else E(acc, cur, wr, wc, fr, fq); } else E(acc, cur, wr, wc, fr, fq);
        if (!has_next) break;
        if (!(Epi::PAIRED && cur.e == 0)) {
#pragma unroll
        for (int a = 0; a < 2; ++a)
#pragma unroll
            for (int b = 0; b < 2; ++b)
#pragma unroll
                for (int m = 0; m < 4; ++m)
#pragma unroll
                    for (int n = 0; n < 2; ++n) acc[a][b][m][n] = (f32x4){0.f, 0.f, 0.f, 0.f}; }
        cur = nxt; cA = nA; cB = nB; ++ui;
        if constexpr (ALIGN_EPI) { if (wr == 1) PG8_BAR; }
    }
    PG8_WAIT_V(0);
    if constexpr (!ALIGN_EPI) { if (wr == 0) PG8_BAR; }
    PG8_BAR;
#undef PG8_SA
#undef PG8_SB
#undef PG8_STAGE
#undef PG8_STAGE_A
#undef PG8_LDA
#undef PG8_LDB
#undef PG8_MMA
#undef PG8_WAIT_V
#undef PG8_WAIT_L
#undef PG8_BAR
#undef PG8_SCHED
}
}

template <bool F8> struct EpiInProjT {
    static constexpr bool PERM = true, FP8 = F8; static constexpr bool PAIRED = false; static constexpr int SCALE_W = 0x79797979, SCALE_X = 0x7d7d7d7d;
    unsigned char* ws;
    DI void operator()(const f32x4 (&acc)[2][2][4][2], const pg8::Unit& u, int wr, int wc, int fr, int fq) const {
        const SegInfo s = seg_of(ws, u.pn * 256);
        const int row0 = u.pm * 256 + wr * 64 + fr, cl0 = s.cl + wc * 32 + 8 * fq;
        const float* ct = nullptr; const float* st = nullptr; int tl = 0, ti = 0;
        if (s.rope == 1) { ct = (const float*)(ws + TAB_COSR); st = (const float*)(ws + TAB_SINR); tl = 64; ti = 16 * wc + 4 * fq; }
        else if (s.rope == 2 && wc == 0) { ct = (const float*)(ws + TAB_COSD); st = (const float*)(ws + TAB_SIND); tl = 16; ti = 4 * fq; }
        const float sc = s.scale;
        const bool kn = !F8 && s.rope == 2 && u.pn >= 32;
        float kmx[2] = {0.f, 0.f};
        if (ct) {
#pragma unroll
            for (int ai = 0; ai < 2; ++ai) {
                f32x4 c4[4], s4[4];
#pragma unroll
                for (int m = 0; m < 4; ++m) { const size_t t = row0 + ai * 128 + m * 16; c4[m] = *(const f32x4*)(ct + t * tl + ti); s4[m] = *(const f32x4*)(st + t * tl + ti); }
#pragma unroll
                for (int m = 0; m < 4; ++m) { bf16_t* rowp = s.base + (size_t)(row0 + ai * 128 + m * 16) * s.ld + cl0; const f32x4 cc = c4[m] * sc, ss = s4[m] * sc;
#pragma unroll
                    for (int bj = 0; bj < 2; ++bj) { const f32x4 v0 = acc[ai][bj][m][0], v1 = acc[ai][bj][m][1];
                        const float o0 = v0[0] * cc[0] - v0[1] * ss[0], o1 = v0[1] * cc[0] + v0[0] * ss[0], o2 = v0[2] * cc[1] - v0[3] * ss[1], o3 = v0[3] * cc[1] + v0[2] * ss[1];
                        const float o4 = v1[0] * cc[2] - v1[1] * ss[2], o5 = v1[1] * cc[2] + v1[0] * ss[2], o6 = v1[2] * cc[3] - v1[3] * ss[3], o7 = v1[3] * cc[3] + v1[2] * ss[3];
                        *(u32x4*)(rowp + bj * 128) = (u32x4){pg8::cvt_pk_bf16(o0, o1), pg8::cvt_pk_bf16(o2, o3), pg8::cvt_pk_bf16(o4, o5), pg8::cvt_pk_bf16(o6, o7)};
                        if (kn) { float q_ = (o0 * o0 + o1 * o1) + (o2 * o2 + o3 * o3) + (o4 * o4 + o5 * o5) + (o6 * o6 + o7 * o7); { auto r16_ = __builtin_amdgcn_permlane16_swap(__float_as_uint(q_), __float_as_uint(q_), false, false); q_ = __uint_as_float(r16_[0]) + __uint_as_float(r16_[1]); auto r32_ = __builtin_amdgcn_permlane32_swap(__float_as_uint(q_), __float_as_uint(q_), false, false); q_ = __uint_as_float(r32_[0]) + __uint_as_float(r32_[1]); } kmx[bj] = fmaxf(kmx[bj], q_); } } } }
        } else {
#pragma unroll
            for (int g = 0; g < 8; ++g) { const int ai = g >> 2, m = g & 3; bf16_t* rowp = s.base + (size_t)(row0 + ai * 128 + m * 16) * s.ld + cl0;
#pragma unroll
                for (int bj = 0; bj < 2; ++bj) { const f32x4 v0 = acc[ai][bj][m][0] * sc, v1 = acc[ai][bj][m][1] * sc;
                    *(u32x4*)(rowp + bj * 128) = (u32x4){pg8::cvt_pk_bf16(v0[0], v0[1]), pg8::cvt_pk_bf16(v0[2], v0[3]), pg8::cvt_pk_bf16(v1[0], v1[1]), pg8::cvt_pk_bf16(v1[2], v1[3])};
                    if (kn) { float q_ = (v0[0] * v0[0] + v0[1] * v0[1]) + (v0[2] * v0[2] + v0[3] * v0[3]) + (v1[0] * v1[0] + v1[1] * v1[1]) + (v1[2] * v1[2] + v1[3] * v1[3]); { auto r16_ = __builtin_amdgcn_permlane16_swap(__float_as_uint(q_), __float_as_uint(q_), false, false); q_ = __uint_as_float(r16_[0]) + __uint_as_float(r16_[1]); auto r32_ = __builtin_amdgcn_permlane32_swap(__float_as_uint(q_), __float_as_uint(q_), false, false); q_ = __uint_as_float(r32_[0]) + __uint_as_float(r32_[1]); } kmx[bj] = fmaxf(kmx[bj], q_); } } }
        }
        if (kn) {
#pragma unroll
            for (int bj = 0; bj < 2; ++bj) { float q_ = kmx[bj];
#define KM_DPP(ctrl) q_ = fmaxf(q_, __int_as_float(__builtin_amdgcn_update_dpp(0, __float_as_int(q_), (ctrl), 0xf, 0xf, true)))
                KM_DPP(0xB1); KM_DPP(0x4E); KM_DPP(0x141); KM_DPP(0x140);
#undef KM_DPP
                if (fr == 0 && fq == 0) atomicMax((unsigned*)(ws + CW_K2) + (((u.pm >> 4) * 8 + (u.pn - 32)) * 2 + bj) * 4 + wc, __float_as_uint(q_)); } }
    }
};
template <int STEP, bool F8 = false> struct EpiProj {
    static constexpr bool PERM = true, FP8 = F8; static constexpr bool PAIRED = false; static constexpr int SCALE_W = 0x79797979, SCALE_X = 0x7d7d7d7d;
    const bf16_t* gates; const bf16_t* tmp_in; bf16_t* out;
    DI void operator()(const f32x4 (&acc)[2][2][4][2], const pg8::Unit& u, int wr, int wc, int fr, int fq) const {
        const int row0 = u.pm * 256 + wr * 64 + fr, col0 = u.pn * 256 + wc * 32 + 8 * fq;
#pragma unroll
        for (int ai = 0; ai < 2; ++ai) {
            u32x4 gw[4][2], tw[4][2];
#pragma unroll
            for (int m = 0; m < 4; ++m)
#pragma unroll
                for (int bj = 0; bj < 2; ++bj) { const size_t t = row0 + ai * 128 + m * 16; const int c = col0 + bj * 128; gw[m][bj] = *(const u32x4*)(gates + t * 4096 + STEP * 2048 + c);
                    if (STEP == 1) tw[m][bj] = *(const u32x4*)(tmp_in + t * DM + c); else tw[m][bj] = (u32x4){0u, 0u, 0u, 0u}; }
#pragma unroll
            for (int m = 0; m < 4; ++m)
#pragma unroll
                for (int bj = 0; bj < 2; ++bj) { const size_t t = row0 + ai * 128 + m * 16; const int c = col0 + bj * 128; float g[8], tp[8], o[8];
                    unpack8(gw[m][bj], g); unpack8(tw[m][bj], tp);
                    const f32x4 v0 = acc[ai][bj][m][0], v1 = acc[ai][bj][m][1];
#pragma unroll
                    for (int j = 0; j < 8; ++j) { const float a = j < 4 ? v0[j & 3] : v1[j & 3]; o[j] = sigmoidf_(g[j]) * a + (STEP == 1 ? tp[j] : 0.f); }
                    *(u32x4*)(out + t * DM + c) = (u32x4){pg8::cvt_pk_bf16(o[0], o[1]), pg8::cvt_pk_bf16(o[2], o[3]), pg8::cvt_pk_bf16(o[4], o[5]), pg8::cvt_pk_bf16(o[6], o[7])}; } }
    }
};
struct EpiOut {
    static constexpr bool PERM = false, FP8 = false; static constexpr bool PAIRED = false; static constexpr int SCALE_W = 0, SCALE_X = 0;
    const float* x; float* y;
    DI void operator()(const f32x4 (&acc)[2][2][4][2], const pg8::Unit& u, int wr, int wc, int fr, int fq) const {
        const int row0 = u.pm * 256 + wr * 64 + fr, col0 = u.pn * 256 + wc * 32 + 4 * fq;
#pragma unroll
        for (int ai = 0; ai < 2; ++ai) {
            f32x4 xv[4][2][2];
#pragma unroll
            for (int m = 0; m < 4; ++m) { const size_t o = (size_t)(row0 + ai * 128 + m * 16) * DM + col0;
#pragma unroll
                for (int bj = 0; bj < 2; ++bj)
#pragma unroll
                    for (int n = 0; n < 2; ++n) xv[m][bj][n] = *(const f32x4*)(x + o + bj * 128 + n * 16); }
#pragma unroll
            for (int m = 0; m < 4; ++m) { const size_t o = (size_t)(row0 + ai * 128 + m * 16) * DM + col0;
#pragma unroll
                for (int bj = 0; bj < 2; ++bj)
#pragma unroll
                    for (int n = 0; n < 2; ++n) *(f32x4*)(y + o + bj * 128 + n * 16) = xv[m][bj][n] * ALPHA + acc[ai][bj][m][n]; } }
    }
};
struct EpiMix {
    static constexpr bool PERM = true, FP8 = false; static constexpr bool PAIRED = false; static constexpr int SCALE_W = 0, SCALE_X = 0;
    bf16_t* y;
    DI void operator()(const f32x4 (&acc)[2][2][4][2], const pg8::Unit& u, int wr, int wc, int fr, int fq) const {
        const int row0 = u.pm * 256 + wr * 64 + fr, col0 = u.pn * 256 + wc * 32 + 8 * fq;
#pragma unroll
        for (int ai = 0; ai < 2; ++ai)
#pragma unroll
            for (int m = 0; m < 4; ++m) { bf16_t* rowp = y + (size_t)(row0 + ai * 128 + m * 16) * DM + col0;
#pragma unroll
                for (int bj = 0; bj < 2; ++bj) { const f32x4 v0 = acc[ai][bj][m][0], v1 = acc[ai][bj][m][1];
                    *(u32x4*)(rowp + bj * 128) = (u32x4){pg8::cvt_pk_bf16(v0[0], v0[1]), pg8::cvt_pk_bf16(v0[2], v0[3]), pg8::cvt_pk_bf16(v1[0], v1[1]), pg8::cvt_pk_bf16(v1[2], v1[3])}; } }
    }
};
struct PairOrder {
    static constexpr bool GATHER = false;
    pg8::StaticOrder S0; const char* A0; const char* A1; const char* B0; const char* B1;
    DI bool next(int i, pg8::Unit& u) const {
        if (!S0.next(i >> 1, u)) return false;
        const int step = i & 1; u.A = (step ? A1 : A0) + (size_t)u.pm * pg8::BM * S0.K * 2; u.B = (step ? B1 : B0) + (size_t)u.pn * pg8::BM * S0.K * 2; u.e = step; return true;
    }
    DI unsigned goff(const pg8::Unit&, int, unsigned) const { return 0u; }
};
struct EpiProjPair {
    static constexpr bool PERM = true, FP8 = true, PAIRED = true; static constexpr int SCALE_W = 0x79797979, SCALE_X = 0x7d7d7d7d;
    const bf16_t* gates; bf16_t* out;
    DI void mid(f32x4 (&acc)[2][2][4][2], const pg8::Unit& u, int wr, int wc, int fr, int fq) const {
        const int row0 = u.pm * 256 + wr * 64 + fr, col0 = u.pn * 256 + wc * 32 + 8 * fq;
#pragma unroll
        for (int ai = 0; ai < 2; ++ai) {
            u32x4 gr[4][2], gd[4][2];
#pragma unroll
            for (int m = 0; m < 4; ++m)
#pragma unroll
                for (int bj = 0; bj < 2; ++bj) { const size_t t = row0 + ai * 128 + m * 16; const int c = col0 + bj * 128; gr[m][bj] = __builtin_nontemporal_load((const u32x4*)(gates + t * 4096 + c)); gd[m][bj] = *(const u32x4*)(gates + t * 4096 + 2048 + c); }
#pragma unroll
            for (int m = 0; m < 4; ++m)
#pragma unroll
                for (int bj = 0; bj < 2; ++bj) { float a[8], d[8]; unpack8(gr[m][bj], a); unpack8(gd[m][bj], d);
#pragma unroll
                    for (int j = 0; j < 8; ++j) { const float r = (1.f + __expf(-d[j])) * __builtin_amdgcn_rcpf(1.f + __expf(-a[j])); acc[ai][bj][m][j >> 2][j & 3] *= r; } } }
    }
    DI void operator()(const f32x4 (&acc)[2][2][4][2], const pg8::Unit& u, int wr, int wc, int fr, int fq) const {
        const int row0 = u.pm * 256 + wr * 64 + fr, col0 = u.pn * 256 + wc * 32 + 8 * fq;
#pragma unroll
        for (int ai = 0; ai < 2; ++ai) {
            u32x4 gd[4][2];
#pragma unroll
            for (int m = 0; m < 4; ++m)
#pragma unroll
                for (int bj = 0; bj < 2; ++bj) { const size_t t = row0 + ai * 128 + m * 16; const int c = col0 + bj * 128; gd[m][bj] = __builtin_nontemporal_load((const u32x4*)(gates + t * 4096 + 2048 + c)); }
#pragma unroll
            for (int m = 0; m < 4; ++m)
#pragma unroll
                for (int bj = 0; bj < 2; ++bj) { const size_t t = row0 + ai * 128 + m * 16; const int c = col0 + bj * 128; float d[8], o[8]; unpack8(gd[m][bj], d);
                    const f32x4 v0 = acc[ai][bj][m][0], v1 = acc[ai][bj][m][1];
#pragma unroll
                    for (int j = 0; j < 8; ++j) o[j] = sigmoidf_(d[j]) * (j < 4 ? v0[j & 3] : v1[j & 3]);
                    *(u32x4*)(out + t * DM + c) = (u32x4){pg8::cvt_pk_bf16(o[0], o[1]), pg8::cvt_pk_bf16(o[2], o[3]), pg8::cvt_pk_bf16(o[4], o[5]), pg8::cvt_pk_bf16(o[6], o[7])}; } }
    }
};
DI void stagger8(int step_sleeps) {
    const int n = ((blockIdx.x >> 3) & 7) * step_sleeps;
    for (int k = 0; k < n; ++k) __builtin_amdgcn_s_sleep(127);
}
DI void f_inproj(const Params& p, LAS unsigned char* lds) {
    if (gridDim.x == 256) prep_fill_skew(p, lds); else stagger8(2);
    if constexpr (GATES_FP8) {
        { pg8::StaticOrder S; S.init((const bf16_t*)(p.ws + WS_XB), (const bf16_t*)(p.ws + WS_WIN), NTOK, 24 * 256, DM, gridDim.x, blockIdx.x); S.split = 8; S.off0 = 0; S.off1 = 16;
          EpiInProjT<false> E{p.ws}; pg8::gemm_phase<EpiInProjT<false>, pg8::StaticOrder, true, true>(lds, DM, S, E); }
        { pg8::StaticOrder S; S.init((const bf16_t*)(p.ws + WS_XB8), (const bf16_t*)(p.ws + WS_WIN8), NTOK, 40 * 256, DM / 2, gridDim.x, blockIdx.x); S.split = 16; S.off0 = 8; S.off1 = 24;
          EpiInProjT<true> E{p.ws}; pg8::gemm_phase<EpiInProjT<true>, pg8::StaticOrder, true, true>(lds, DM / 2, S, E); }
    } else {
        pg8::StaticOrder S; S.init((const bf16_t*)(p.ws + WS_XB), (const bf16_t*)(p.ws + WS_WIN), NTOK, NIN, DM, gridDim.x, blockIdx.x);
        EpiInProjT<false> E{p.ws}; pg8::gemm_phase<EpiInProjT<false>, pg8::StaticOrder, true, true>(lds, DM, S, E);
    }
}
DI void f_proj(const Params& p, LAS unsigned char* lds) {
    unsigned char* ws = p.ws;
    if constexpr (PROJ_FP8) {
    { PairOrder S; S.S0.init((const bf16_t*)(ws + WS_RETA8), (const bf16_t*)(ws + WS_WR), NTOK, DM, DM / 2, gridDim.x, blockIdx.x);
      S.A0 = (const char*)(ws + WS_RETA8); S.A1 = (const char*)(ws + WS_DIFFA8); S.B0 = (const char*)(ws + WS_WR); S.B1 = (const char*)(ws + WS_WD);
      EpiProjPair E{(const bf16_t*)(ws + WS_GATES), (bf16_t*)(ws + WS_MERGED)};
      pg8::gemm_phase<EpiProjPair, PairOrder, true, true>(lds, DM / 2, S, E); }
    } else if constexpr (false) {
    { pg8::StaticOrder S; S.init((const bf16_t*)(ws + WS_RETA8), (const bf16_t*)(ws + WS_WR), NTOK, DM, DM / 2, gridDim.x, blockIdx.x);
      EpiProj<0, true> E{(const bf16_t*)(ws + WS_GATES), nullptr, (bf16_t*)(ws + WS_TMP)};
      pg8::gemm_phase<EpiProj<0, true>, pg8::StaticOrder, true, true>(lds, DM / 2, S, E); }
    { pg8::StaticOrder S; S.init((const bf16_t*)(ws + WS_DIFFA8), (const bf16_t*)(ws + WS_WD), NTOK, DM, DM / 2, gridDim.x, blockIdx.x);
      EpiProj<1, true> E{(const bf16_t*)(ws + WS_GATES), (const bf16_t*)(ws + WS_TMP), (bf16_t*)(ws + WS_MERGED)};
      pg8::gemm_phase<EpiProj<1, true>, pg8::StaticOrder, true, true>(lds, DM / 2, S, E); }
    } else {
    { pg8::StaticOrder S; S.init((const bf16_t*)p.out, (const bf16_t*)(ws + WS_WR), NTOK, DM, DM, gridDim.x, blockIdx.x);
      EpiProj<0> E{(const bf16_t*)(ws + WS_GATES), nullptr, (bf16_t*)(ws + WS_TMP)};
      pg8::gemm_phase<EpiProj<0>, pg8::StaticOrder, true, true>(lds, DM, S, E); }
    { pg8::StaticOrder S; S.init((const bf16_t*)(ws + WS_DIFFA), (const bf16_t*)(ws + WS_WD), NTOK, DM, DM, gridDim.x, blockIdx.x);
      EpiProj<1> E{(const bf16_t*)(ws + WS_GATES), (const bf16_t*)(ws + WS_TMP), (bf16_t*)(ws + WS_MERGED)};
      pg8::gemm_phase<EpiProj<1>, pg8::StaticOrder, true, true>(lds, DM, S, E); }
    }
}
DI void f_outproj(const Params& p, LAS unsigned char* lds) {
    pg8::StaticOrder S; S.init((const bf16_t*)(p.ws + WS_MERGED), (const bf16_t*)(p.ws + WS_WO), NTOK, DM, DM, gridDim.x, blockIdx.x);
    EpiMix E{(bf16_t*)p.out};
    pg8::gemm_phase<EpiMix, pg8::StaticOrder, true, true>(lds, DM, S, E);
}

constexpr int LDS_MOE_TAB = 131072;
constexpr int LDS_MOE_TOK = 131072 + 1024;
template <bool UP> struct MoeOrder {
    static constexpr bool GATHER = UP;
    const char* gbase; const char* A; const char* Bt; int K; size_t estride; int G, c, v;
    LAS const int* tab; LAS const int* tok;
    DI void init(const void* gb, const void* A_, const void* Bt_, int K_, size_t es, LAS unsigned char* lds) { gbase = (const char*)gb; A = (const char*)A_; Bt = (const char*)Bt_; K = K_; estride = es; G = gridDim.x; c = blockIdx.x;
        v = (G % 8 == 0) ? (c % 8) * (G / 8) + c / 8 : c; tab = (LAS const int*)(lds + LDS_MOE_TAB); tok = (LAS const int*)(lds + LDS_MOE_TOK); }
    DI bool next(int i, pg8::Unit& u) const {
        const int L = i * G + v, np = tab[0]; if (L >= np * 8) return false;
        const int panel = L >> 3, nt = L & 7, pk = tab[65 + panel], e = pk >> 8, mt = pk & 255, cnt = tab[1 + e], base = tab[33 + e];
        u.e = e; u.rows = cnt - mt * 256 < 256 ? cnt - mt * 256 : 256; u.rowbase = base + mt * 256; u.slot0 = mt * 256; u.pm = i; u.pn = nt;
        u.A = A + (size_t)u.rowbase * K * 2; u.B = Bt + (size_t)e * estride + (size_t)nt * 256 * K * 2; return true;
    }
    DI unsigned goff(const pg8::Unit& u, int hh, unsigned pk) const { return (unsigned)tok[u.pm * 256 + hh * 128 + (int)(pk >> 8)] * (unsigned)(K * 2) + (pk & 255u) * 2u; }
};
DI void moe_tables(const Params& p, LAS unsigned char* lds) {
    LAS int* tab = (LAS int*)(lds + LDS_MOE_TAB); const int* cnt = (const int*)(p.ws + RT_CNT);
    if (threadIdx.x == 0) { int np = 0, base = 0;
        for (int e = 0; e < NEXP; ++e) { const int c = cnt[e], mt = (c + 255) >> 8; tab[1 + e] = c; tab[33 + e] = base; for (int m = 0; m < mt; ++m) tab[65 + np + m] = e * 256 + m; np += mt; base += mt * 256; }
        tab[0] = np; }
    __syncthreads();
}
struct EpiSwiGLU {
    static constexpr bool PERM = true, FP8 = true; static constexpr bool PAIRED = false; static constexpr int SCALE_W = 0x79797979, SCALE_X = 0x7d7d7d7d;
    unsigned char* act;
    DI void operator()(const f32x4 (&acc)[2][2][4][2], const pg8::Unit& u, int wr, int wc, int fr, int fq) const {
        const int col0 = u.pn * 128 + wc * 32 + 8 * fq;
#pragma unroll
        for (int ai = 0; ai < 2; ++ai)
#pragma unroll
            for (int m = 0; m < 4; ++m) { const int rl = ai * 128 + wr * 64 + m * 16 + fr;
                if (rl < u.rows) { float o[8];
#pragma unroll
                    for (int j = 0; j < 8; ++j) { const float g = acc[ai][0][m][j >> 2][j & 3], up = acc[ai][1][m][j >> 2][j & 3]; o[j] = g * sigmoidf_(g) * up; }
                    *(u32x2*)(act + (size_t)(u.rowbase + rl) * FF + col0) = (u32x2){pk4_fp8(o[0] * F8_SACT, o[1] * F8_SACT, o[2] * F8_SACT, o[3] * F8_SACT), pk4_fp8(o[4] * F8_SACT, o[5] * F8_SACT, o[6] * F8_SACT, o[7] * F8_SACT)}; } }
    }
};
struct EpiDown {
    static constexpr bool PERM = true, FP8 = true; static constexpr bool PAIRED = false; static constexpr int SCALE_W = 0x79797979, SCALE_X = 0x7c7c7c7c;
    bf16_t* ykc;
    DI void operator()(const f32x4 (&acc)[2][2][4][2], const pg8::Unit& u, int wr, int wc, int fr, int fq) const {
        const int col0 = u.pn * 256 + wc * 32 + 8 * fq;
#pragma unroll
        for (int g = 0; g < 8; ++g) { const int ai = g >> 2, m = g & 3, rl = ai * 128 + wr * 64 + m * 16 + fr;
            bf16_t* rowp = ykc + (size_t)(u.rowbase + rl) * DM + col0;
#pragma unroll
            for (int bj = 0; bj < 2; ++bj) { const f32x4 v0 = acc[ai][bj][m][0], v1 = acc[ai][bj][m][1];
                *(u32x4*)(rowp + bj * 128) = (u32x4){pg8::cvt_pk_bf16(v0[0], v0[1]), pg8::cvt_pk_bf16(v0[2], v0[3]), pg8::cvt_pk_bf16(v1[0], v1[1]), pg8::cvt_pk_bf16(v1[2], v1[3])}; } }
    }
};
DI void f_moe_up(const Params& p, LAS unsigned char* lds) {
    unsigned char* ws = p.ws;
    moe_tables(p, lds);
    MoeOrder<true> S; S.init(ws + WS_HB8, nullptr, ws + WS_WGU, DM / 2, (size_t)2048 * DM, lds);
    { LAS int* tok = (LAS int*)(lds + LDS_MOE_TOK); const int* st = (const int*)(ws + RT_SLOTTOK);
      for (int i = 0; i < 5; ++i) { pg8::Unit u; if (S.next(i, u) && threadIdx.x < 256) { int r = threadIdx.x; if (r > u.rows - 1) r = u.rows - 1; tok[i * 256 + threadIdx.x] = st[u.e * NTOK + u.slot0 + r]; } }
      __syncthreads(); }
    EpiSwiGLU E{(unsigned char*)(ws + WS_ACT)};
    pg8::gemm_phase<EpiSwiGLU, MoeOrder<true>, true, true>(lds, DM / 2, S, E);
}
DI void f_moe_down(const Params& p, LAS unsigned char* lds) {
    unsigned char* ws = p.ws;
    moe_tables(p, lds);
    MoeOrder<false> S; S.init(nullptr, ws + WS_ACT, ws + WS_WDN, FF / 2, (size_t)DM * FF, lds);
    EpiDown E{(bf16_t*)(ws + WS_YKC)};
    pg8::gemm_phase<EpiDown, MoeOrder<false>, true, true>(lds, FF / 2, S, E);
}


namespace att {
using bf16 = bf16_t;
constexpr int D = 128, LD = 2048;
constexpr float THR = 8.f;
constexpr bool WSKIP = false;
constexpr float SCALE = 0.08838834764831845f;
constexpr int NW = 8, QBLK = 32, KVBLK = 64, QB = NW * QBLK;
constexpr int SHM_V = KVBLK * D * 2, SHM_K = KVBLK * D * 2;
constexpr int LDS_BYTES = 2 * SHM_V + 2 * SHM_K + NW * 64 * 4;
typedef short s16x4 __attribute__((ext_vector_type(4)));


typedef short s16x4 __attribute__((ext_vector_type(4)));


template <class A, class Bt> struct same_t { static constexpr bool v = false; };
template <class A> struct same_t<A, A> { static constexpr bool v = true; };

#define KSWZ(row, colB) ((row) * 256 + ((colB) ^ (((row) & 7) << 4)))
#define SBAR() __builtin_amdgcn_sched_barrier(0)
__device__ __forceinline__ int v_st(int k, int c) { const int kk = (k & ~0xC) | ((k & 4) << 1) | ((k & 8) >> 1); return ((kk >> 3) * 4 + (c >> 5)) * 512 + ((kk & 7) * 32 + (c & 31)) * 2; }
__device__ __forceinline__ int v_rd_base(int lane) { return ((lane & 3) << 3) | (((lane >> 2) & 3) << 6) | (((lane >> 4) & 1) << 5) | (((lane >> 5) & 1) << 8); }
constexpr int v_rd_off(int d0, int ks, int half) { return d0 * 512 + ks * 4096 + half * 2048; }
__device__ __forceinline__ int crow(int r, int hi) { return (r & 3) + 8 * (r >> 2) + 4 * hi; }
__device__ __forceinline__ unsigned cvtpk(float lo, float hi) {
    unsigned r; asm volatile("v_cvt_pk_bf16_f32 %0, %1, %2" : "=v"(r) : "v"(lo), "v"(hi)); return r;
}
__device__ __forceinline__ bf16x8 pack8(f32x4 a, f32x4 b) {
    u32x4 w = {cvtpk(a[0], a[1]), cvtpk(a[2], a[3]), cvtpk(b[0], b[1]), cvtpk(b[2], b[3])};
    return *reinterpret_cast<bf16x8*>(&w);
}
template <class T> __device__ __forceinline__ bf16x8 load8(const T* p) {
    if constexpr (same_t<T, float>::v) { return pack8(*(const f32x4*)p, *(const f32x4*)(p + 4)); }
    else { return *reinterpret_cast<const bf16x8*>(p); }
}
template <int MODE> __device__ __forceinline__ void mask_tile(f32x16& p0, f32x16& p1, int dq, unsigned W) {
    const float NEG = MODE ? 0.f : -__builtin_inff();
#pragma unroll
    for (int r = 0; r < 16; ++r) {
        const int c = (r & 3) + 8 * (r >> 2);
        if ((unsigned)(dq - c) >= W) p0[r] = NEG;
        if ((unsigned)(dq - c - 32) >= W) p1[r] = NEG;
    }
}
template <int MODE> __device__ __forceinline__ void partialSM(f32x16& p0, f32x16& p1, float& m_reg, float& mn, float& alpha, float fd, float lg) {
    if constexpr (MODE == 1) { alpha = 1.f; mn = 0.f;
        for (int r = 0; r < 16; ++r) { const float c = (float)((r & 3) + 8 * (r >> 2)); p0[r] *= __builtin_amdgcn_exp2f(lg * __builtin_fabsf(fd - c)); }
        return; }
    float pmax = p0[0]; for (int r = 1; r < 16; ++r) pmax = fmaxf(pmax, p0[r]); for (int r = 0; r < 16; ++r) pmax = fmaxf(pmax, p1[r]);
    { auto rr = __builtin_amdgcn_permlane32_swap(__float_as_uint(pmax), __float_as_uint(pmax), false, false);
      pmax = fmaxf(__uint_as_float(rr[0]), __uint_as_float(rr[1])); }
    constexpr float C2 = 1.4426950408889634f * SCALE;
    if (__builtin_expect(__all((pmax - m_reg) * SCALE <= THR), 1)) { mn = m_reg; alpha = 1.f; }
    else { mn = fmaxf(m_reg, pmax); alpha = __builtin_amdgcn_exp2f((m_reg - mn) * C2); m_reg = mn; }
    const float mnL = -mn * C2;
    for (int r = 0; r < 16; ++r) p0[r] = fmaf(p0[r], C2, mnL); for (int r = 0; r < 16; ++r) p1[r] = fmaf(p1[r], C2, mnL);
    for (int r = 0; r < 16; ++r) p0[r] = __builtin_amdgcn_exp2f(p0[r]);
}
template <int MODE> __device__ __forceinline__ void finishSM(f32x16& p0, f32x16& p1, float alpha, float& l_reg, bf16x8& pa0, bf16x8& pa1, bf16x8& pa2, bf16x8& pa3, float fd, float lg) {
    if constexpr (MODE == 1) { for (int r = 0; r < 16; ++r) { const float c = (float)((r & 3) + 8 * (r >> 2) + 32); p1[r] *= __builtin_amdgcn_exp2f(lg * __builtin_fabsf(fd - c)); } }
    else {
    for (int r = 0; r < 16; ++r) p1[r] = __builtin_amdgcn_exp2f(p1[r]);
    float ps = 0; for (int r = 0; r < 16; ++r) ps += p0[r]; for (int r = 0; r < 16; ++r) ps += p1[r];
    { auto rr = __builtin_amdgcn_permlane32_swap(__float_as_uint(ps), __float_as_uint(ps), false, false);
      ps = __uint_as_float(rr[0]) + __uint_as_float(rr[1]); }
    l_reg = l_reg * alpha + ps; }
#define PK4(P, B_, OUT) do { unsigned a0 = cvtpk(P[B_+0], P[B_+1]), a1 = cvtpk(P[B_+2], P[B_+3]);                          \
        unsigned b0 = cvtpk(P[B_+4], P[B_+5]), b1 = cvtpk(P[B_+6], P[B_+7]);                                             \
        auto r0 = __builtin_amdgcn_permlane32_swap(a0, b0, false, false); auto r1 = __builtin_amdgcn_permlane32_swap(a1, b1, false, false); \
        u32x4 w = {r0[0], r1[0], r0[1], r1[1]}; OUT = *reinterpret_cast<bf16x8*>(&w); } while (0)
    PK4(p0, 0, pa0); PK4(p0, 8, pa1); PK4(p1, 0, pa2); PK4(p1, 8, pa3);
#undef PK4
}
template <int KB, bool SK>
__device__ __forceinline__ void qkt(f32x16& p0, f32x16& p1, const char* K_lds, int r32, int hi, const bf16x8* qr, bool act) {
    if (SK && !act) { const float NEG = -__builtin_inff();
#pragma unroll
        for (int r = 0; r < 16; ++r) { p0[r] = NEG; p1[r] = NEG; } return; }
    p0 = f32x16{}; p1 = f32x16{};
    const char* kb[4];
#pragma unroll
    for (int dd = 0; dd < 4; ++dd) kb[dd] = K_lds + KB * SHM_K + KSWZ(r32, (dd * 16 + hi * 8) * 2);
#pragma unroll
    for (int d0 = 0; d0 < 8; ++d0) { const char* a = kb[d0 & 3] + (d0 >> 2) * 128;
        bf16x8 b0 = *reinterpret_cast<const bf16x8*>(a);
        bf16x8 b1 = *reinterpret_cast<const bf16x8*>(a + 32 * 256);
        p0 = __builtin_amdgcn_mfma_f32_32x32x16_bf16(b0, qr[d0], p0, 0, 0, 0);
        p1 = __builtin_amdgcn_mfma_f32_32x32x16_bf16(b1, qr[d0], p1, 0, 0, 0); }
}
template <int VB, bool SK>
__device__ __forceinline__ void pv_tile(f32x16* o, int vb0, bf16x8 pa0, bf16x8 pa1, bf16x8 pa2, bf16x8 pa3, bool act) {
    if (SK && !act) return;
#define TRRD(dst, off) asm volatile("ds_read_b64_tr_b16 %0, %1 offset:%2" : "=&v"(dst) : "v"(vb0), "i"(off) : "memory")
#define PV_D0(d0) do { s16x4 l0, l1, l2, l3, h0, h1, h2, h3; constexpr int b_ = VB * SHM_V + v_rd_off(d0, 0, 0);     \
        TRRD(l0, b_); TRRD(h0, b_ + 2048); TRRD(l1, b_ + 4096); TRRD(h1, b_ + 6144); TRRD(l2, b_ + 8192); TRRD(h2, b_ + 10240); TRRD(l3, b_ + 12288); TRRD(h3, b_ + 14336); \
        asm volatile("s_waitcnt lgkmcnt(0)" ::: "memory"); SBAR();                 \
        o[d0] = __builtin_amdgcn_mfma_f32_32x32x16_bf16(pa0, (bf16x8){l0[0], l0[1], l0[2], l0[3], h0[0], h0[1], h0[2], h0[3]}, o[d0], 0, 0, 0);   \
        o[d0] = __builtin_amdgcn_mfma_f32_32x32x16_bf16(pa1, (bf16x8){l1[0], l1[1], l1[2], l1[3], h1[0], h1[1], h1[2], h1[3]}, o[d0], 0, 0, 0);   \
        o[d0] = __builtin_amdgcn_mfma_f32_32x32x16_bf16(pa2, (bf16x8){l2[0], l2[1], l2[2], l2[3], h2[0], h2[1], h2[2], h2[3]}, o[d0], 0, 0, 0);   \
        o[d0] = __builtin_amdgcn_mfma_f32_32x32x16_bf16(pa3, (bf16x8){l3[0], l3[1], l3[2], l3[3], h3[0], h3[1], h3[2], h3[3]}, o[d0], 0, 0, 0); } while (0)
    PV_D0(0); PV_D0(1); PV_D0(2); PV_D0(3);
#undef PV_D0
#undef TRRD
}

template <class TIn, class TOut> struct BlockRef { const TIn* Q; const TIn* K; const TIn* V; TOut* O; int P0; float lg; int jlo; const unsigned short* s0; };
template <class TIn> struct Seam {
    bf16x8 qr[8];
    bf16x8 st_v0, st_v1, st_k0, st_k1; f32x4 sf0, sf1, sf2, sf3;
    f32x4 tq[16];
};
__device__ __forceinline__ int swa_jlo(int P0, int W) { const int lowk = P0 - W + 1; return lowk > 0 ? lowk / KVBLK : 0; }
#define ROW(p, k0, rr, ld_) ((p) + (size_t)((k0) + (rr)) * (ld_) + sc)
#define VMW() asm volatile("s_waitcnt vmcnt(0)" ::: "memory")
#define VMWN(n) asm volatile("s_waitcnt vmcnt(%0)" :: "i"(n) : "memory")
#define SLOAD_H(Kp, Vp, k0, R_) do { S.st_v0 = load8<TIn>(ROW(Vp, k0, sr, LD)); S.st_v1 = load8<TIn>(ROW(Vp, k0, 32 + sr, LD));              \
                         S.st_k0 = load8<TIn>(ROW(Kp, k0, sr, LD)); S.st_k1 = load8<TIn>(ROW(Kp, k0, 32 + sr, LD)); } while (0)
#define SWRITE_HK(bf) do { *(bf16x8*)(K_lds + (bf) * SHM_K + kws) = S.st_k0; *(bf16x8*)(K_lds + (bf) * SHM_K + kws + 32 * 256) = S.st_k1; } while (0)
#define SWRITE_HV(bf) do { *(bf16x8*)(V_lds + (bf) * SHM_V + vst0) = S.st_v0; *(bf16x8*)(V_lds + (bf) * SHM_V + vst1) = S.st_v1; } while (0)
#define SWRITE_H(bf) do { SWRITE_HV(bf); SWRITE_HK(bf); } while (0)
#define SLOAD_F(p, k0) do { S.sf0 = *(const f32x4*)ROW(p, k0, sr, LD); S.sf1 = *(const f32x4*)(ROW(p, k0, sr, LD) + 4);                \
                            S.sf2 = *(const f32x4*)ROW(p, k0, 32 + sr, LD); S.sf3 = *(const f32x4*)(ROW(p, k0, 32 + sr, LD) + 4); } while (0)
#define SWRITE_KF(bf) do { *(bf16x8*)(K_lds + (bf) * SHM_K + kws) = pack8(S.sf0, S.sf1); *(bf16x8*)(K_lds + (bf) * SHM_K + kws + 32 * 256) = pack8(S.sf2, S.sf3); } while (0)
#define SWRITE_VF(bf) do { *(bf16x8*)(V_lds + (bf) * SHM_V + vst0) = pack8(S.sf0, S.sf1); *(bf16x8*)(V_lds + (bf) * SHM_V + vst1) = pack8(S.sf2, S.sf3); } while (0)
template <class TIn, class TOut>
__device__ __forceinline__ void causal_swa_prime(const BlockRef<TIn, TOut>& cur, int W, char* lds, Seam<TIn>& S) {
    constexpr bool F32 = same_t<TIn, float>::v;
    int tid_ = threadIdx.x; asm volatile("" : "+v"(tid_)); const int tid = tid_, wid = __builtin_amdgcn_readfirstlane(tid >> 6), lane = tid & 63, r32 = lane & 31, hi = lane >> 5;
    const int sr = tid >> 4, sc = (tid & 15) * 8, kws = KSWZ(sr, sc * 2); char* K_lds = lds + 2 * SHM_V;
    const int kb0 = cur.jlo * KVBLK;
    for (int d0 = 0; d0 < 8; ++d0) S.qr[d0] = load8<TIn>(cur.Q + (size_t)(wid * QBLK + r32) * LD + d0 * 16 + hi * 8);
    if constexpr (F32) { SLOAD_F((const float*)cur.K, kb0); VMW(); SWRITE_KF(0); SBAR(); SLOAD_F((const float*)cur.V, kb0); }
    else { SLOAD_H(cur.K, cur.V, kb0, cur); VMW(); SWRITE_HK(0); }
    __syncthreads();
}
template <int MODE, class TIn, class TOut>
__device__ __forceinline__ void causal_swa_block(const BlockRef<TIn, TOut>& cur, const BlockRef<TIn, TOut>& nxt, int skv, int W, char* lds, Seam<TIn>& S) {
    constexpr bool F32 = same_t<TIn, float>::v;
    int tid_ = threadIdx.x; asm volatile("" : "+v"(tid_)); const int tid = tid_, wid = __builtin_amdgcn_readfirstlane(tid >> 6), lane = tid & 63, r32 = lane & 31, hi = lane >> 5;
    const int j_lo = cur.jlo;
    int j_hi = (cur.P0 + QB - 1) / KVBLK + 1; if (j_hi > skv / KVBLK) j_hi = skv / KVBLK;
    const int NT = j_hi - j_lo;
    const int kbn = nxt.jlo * KVBLK;
    const int qlo = cur.P0 + wid * QBLK, qm = ((qlo + r32) | 63) - 4 * hi;
    char* V_lds = lds; char* K_lds = lds + 2 * SHM_V;
    float* ws = (float*)(lds + 2 * SHM_V + 2 * SHM_K) + wid * 64; float* li_l = ws, * al_l = ws + 32;
    float m_reg = -1e30f, l_reg = 0; f32x16 o[4] = {};
    if constexpr (MODE == 1) { if (cur.s0) {
#pragma unroll
        for (int dv = 0; dv < 4; ++dv) {
#pragma unroll
            for (int st = 0; st < 8; ++st) { const bf16x8 sf = *reinterpret_cast<const bf16x8*>(cur.s0 + (size_t)(dv * 32 + r32) * 128 + st * 16 + hi * 8); o[dv] = __builtin_amdgcn_mfma_f32_32x32x16_bf16(S.qr[st], sf, o[dv], 0, 0, 0); } }
#pragma unroll
        for (int r = 0; r < 16; ++r) { const float f = __builtin_amdgcn_exp2f(cur.lg * (float)(cur.P0 + wid * QBLK + crow(r, hi) - j_lo * KVBLK + 1));
#pragma unroll
            for (int dv = 0; dv < 4; ++dv) o[dv][r] *= f; } } }
    const int sr = tid >> 4, sc = (tid & 15) * 8, vst0 = v_st(sr, sc), vst1 = v_st(32 + sr, sc), kws = KSWZ(sr, sc * 2);
    const int vb0 = (int)(uintptr_t)V_lds + v_rd_base(lane);
    const TIn* Kh = cur.K; const TIn* Vh = cur.V;
#define RESC(a) do { if (__any((a) < 1.f)) { if (hi == 0) al_l[r32] = (a); asm volatile("s_waitcnt lgkmcnt(0)" ::: "memory");              \
                     for (int d_ = 0; d_ < 4; ++d_) for (int r = 0; r < 16; ++r) o[d_][r] *= al_l[crow(r, hi)]; } } while (0)
#define KBASE(t) ((j_lo + (t)) * KVBLK)
#define FD(t) ((float)(qlo + r32 - 4 * hi - KBASE(t)))
#define ACT(t) (KBASE(t) <= qlo + QBLK - 1 && KBASE(t) + KVBLK - 1 >= qlo - W + 1)
#define MASKT(P0_, P1_, t) do { const int kb_ = KBASE(t); if ((!SK || ACT(t)) && (kb_ + KVBLK - 1 > qlo || kb_ <= qlo + QBLK - 1 - W)) mask_tile<MODE>(P0_, P1_, qm - kb_, (unsigned)W); } while (0)
    constexpr int NQL = F32 ? 16 : 8;
    constexpr bool SK = WSKIP && !F32;
#define SEAM_K0() do { VMWN(NQL); if constexpr (F32) { SWRITE_KF(0); SBAR(); SLOAD_F((const float*)nxt.V, kbn); } else { SWRITE_HK(0); } SBAR(); } while (0)
    f32x16 pA0, pA1, pB0, pB1; float mnA, mnB, alA, alB; bf16x8 pa0, pa1, pa2, pa3;
    if constexpr (F32) { VMW(); SWRITE_VF(0); SBAR(); } else { SWRITE_HV(0); SBAR(); }
    if (NT > 1) { if constexpr (F32) SLOAD_F((const float*)Kh, KBASE(1)); else SLOAD_H(Kh, Vh, KBASE(1), cur); }
    SBAR(); qkt<0, SK>(pA0, pA1, K_lds, r32, hi, S.qr, ACT(0));
    if constexpr (F32) { if (NT > 1) { VMW(); SWRITE_KF(1); SBAR(); SLOAD_F((const float*)Vh, KBASE(1)); } }
    MASKT(pA0, pA1, 0); partialSM<MODE>(pA0, pA1, m_reg, mnA, alA, FD(0), cur.lg);
    if (NT > 1) { VMW(); if constexpr (F32) { SWRITE_VF(1); SBAR(); if (NT > 2) SLOAD_F((const float*)Kh, KBASE(2)); } else SWRITE_H(1); }
    __syncthreads();
#define HALF_STEP(PX0, PX1, mnX, alX, PY0, PY1, alY, t, KB, VB, SB) do {                                                      \
        SBAR(); qkt<KB, SK>(PX0, PX1, K_lds, r32, hi, S.qr, ACT(t));                                             \
        finishSM<MODE>(PY0, PY1, alY, l_reg, pa0, pa1, pa2, pa3, FD((t) - 1), cur.lg); SBAR();                                                           \
        if ((t) + 1 < NT) { if constexpr (F32) { VMW(); SWRITE_KF(SB); SBAR(); SLOAD_F((const float*)Vh, KBASE((t) + 1)); }  \
                            else { SLOAD_H(Kh, Vh, KBASE((t) + 1), cur); } SBAR(); }                                               \
        pv_tile<VB, SK>(o, vb0, pa0, pa1, pa2, pa3, ACT((t) - 1)); MASKT(PX0, PX1, (t)); partialSM<MODE>(PX0, PX1, m_reg, mnX, alX, FD(t), cur.lg);                                        \
        __syncthreads();                                                                                                      \
        if ((t) + 1 < NT) { VMW(); if constexpr (F32) { SWRITE_VF(SB); SBAR(); if ((t) + 2 < NT) SLOAD_F((const float*)Kh, KBASE((t) + 2)); } \
                            else { SWRITE_H(SB); } }                                                                          \
        RESC(alX); __syncthreads(); } while (0)
    for (int t = 1; t + 1 < NT; t += 2) {
        HALF_STEP(pB0, pB1, mnB, alB, pA0, pA1, alA, t, 1, 0, 0);
        HALF_STEP(pA0, pA1, mnA, alA, pB0, pB1, alB, t + 1, 0, 1, 1);
    }
    const bool even = (NT & 1) == 0;
    if (even) { SBAR(); qkt<1, SK>(pB0, pB1, K_lds, r32, hi, S.qr, ACT(NT - 1)); SBAR(); }
#define QROW(e) (nxt.Q + (size_t)(wid * QBLK + r32) * LD + ((e) >> 1) * 16 + hi * 8 + ((e) & 1) * 4)
    if constexpr (F32) { SLOAD_F((const float*)nxt.K, kbn); SBAR();
#pragma unroll
        for (int e = 0; e < 8; ++e) S.tq[e] = *(const f32x4*)QROW(e); }
    else { SLOAD_H(nxt.K, nxt.V, kbn, nxt); SBAR();
#pragma unroll
        for (int d0 = 0; d0 < 8; ++d0) S.qr[d0] = load8<TIn>(nxt.Q + (size_t)(wid * QBLK + r32) * LD + d0 * 16 + hi * 8); }
    SBAR();
    finishSM<MODE>(pA0, pA1, alA, l_reg, pa0, pa1, pa2, pa3, FD(even ? NT - 2 : NT - 1), cur.lg); SBAR();
    if constexpr (F32) {
#pragma unroll
        for (int e = 8; e < 16; ++e) S.tq[e] = *(const f32x4*)QROW(e); SBAR(); }
#undef QROW
    pv_tile<0, SK>(o, vb0, pa0, pa1, pa2, pa3, ACT(even ? NT - 2 : NT - 1));
    if (even) { MASKT(pB0, pB1, NT - 1); partialSM<MODE>(pB0, pB1, m_reg, mnB, alB, FD(NT - 1), cur.lg); __syncthreads(); RESC(alB);
        finishSM<MODE>(pB0, pB1, alB, l_reg, pa0, pa1, pa2, pa3, FD(NT - 1), cur.lg); SBAR(); pv_tile<1, SK>(o, vb0, pa0, pa1, pa2, pa3, ACT(NT - 1)); }
    SBAR(); SEAM_K0();
    if (hi == 0) li_l[r32] = l_reg; asm volatile("s_waitcnt lgkmcnt(0)" ::: "memory");
    float rli[16];
#pragma unroll
    for (int r = 0; r < 16; ++r) rli[r] = MODE ? 1.f : __builtin_amdgcn_rcpf(li_l[crow(r, hi)]);
    TOut* Ow = cur.O + (size_t)(wid * QBLK) * LD;
#pragma unroll
    for (int r = 0; r < 16; ++r) { const int orow = crow(r, hi);
#pragma unroll
        for (int d0 = 0; d0 < 4; ++d0) { const float v = o[d0][r] * rli[r];
            if constexpr (same_t<TOut, float>::v) { Ow[(size_t)orow * LD + d0 * 32 + r32] = v; }
            else { const float vn = __shfl_xor(v, 1);
                   if ((r32 & 1) == 0) *(unsigned*)(Ow + (size_t)orow * LD + d0 * 32 + r32) = cvtpk(v, vn); } } }
    if constexpr (F32) {
#pragma unroll
        for (int d0 = 0; d0 < 8; ++d0) S.qr[d0] = pack8(S.tq[2 * d0], S.tq[2 * d0 + 1]); }
    __syncthreads();
#undef RESC
#undef KBASE
#undef FD
#undef ACT
#undef MASKT
#undef SEAM_K0
#undef HALF_STEP
}
#undef ROW
#undef VMW
#undef VMWN
#undef SLOAD_H
#undef SWRITE_HK
#undef SWRITE_HV
#undef SWRITE_H
#undef SLOAD_F
#undef SWRITE_KF
#undef SWRITE_VF
}
constexpr int N_RET_ITEMS = 512, N_ATT_ITEMS = 1024;
DI att::BlockRef<bf16_t, bf16_t> mix_ref(const Params& p, int item, int pass) {
    unsigned char* ws = p.ws; att::BlockRef<bf16_t, bf16_t> r;
    if (item < N_RET_ITEMS) { const int prob = item >> 3, x = item & 7, qb = pass ? 15 - x : x; const int vh = prob & 1, h = (prob >> 1) & 7, b = prob >> 4; const size_t t0 = (size_t)b * SEQ;
        r.Q = (const bf16_t*)(ws + WS_RQ) + (t0 + (size_t)qb * 256) * 2048 + h * 128; r.K = (const bf16_t*)(ws + WS_RQ) + t0 * 2048 + 1024 + h * 128;
        r.V = (const bf16_t*)(ws + WS_RV) + t0 * 2048 + h * 256 + vh * 128; r.O = (bf16_t*)p.out + (t0 + (size_t)qb * 256) * 2048 + h * 256 + vh * 128;
        r.P0 = qb * 256; r.lg = log2f(1.f - exp2f(-5.f - (float)h)); const int seg = qb >> 1; r.jlo = seg * 8;
        r.s0 = seg ? (const unsigned short*)((bf16_t*)p.out + (size_t)32 * MiB) + ((size_t)((b * 8 + h) * 7 + seg - 1) * 256 + vh * 128) * 128 : nullptr; return r; }
    item -= N_RET_ITEMS;
    const int prob = item >> 3, x = item & 7, qb = pass ? 15 - x : x;
    const int vh = prob & 1, i = (prob >> 1) & 1, h = (prob >> 2) & 7, b = prob >> 5;
    const size_t t0 = (size_t)b * SEQ, hc = (size_t)h * 256;
    r.Q = (const bf16_t*)(ws + WS_DQ) + (t0 + (size_t)qb * 256) * 2048 + hc + i * 128;
    r.K = (const bf16_t*)(ws + WS_DK) + t0 * 2048 + hc + i * 128;
    r.V = (const bf16_t*)(ws + WS_DV) + t0 * 2048 + hc + vh * 128;
    r.O = (bf16_t*)(ws + (i ? WS_O1 : WS_O0)) + (t0 + (size_t)qb * 256) * 2048 + hc + vh * 128;
    r.P0 = qb * 256; r.lg = 0.f; r.jlo = 0; r.s0 = nullptr;
    return r;
}
template <int MODE> DI void mix_stream(const Params& p, char* lds, int first, int total) {
    constexpr int W = 1 << 30;
    const int stride = gridDim.x; int L = first + blockIdx.x; if (L >= total) return;
    int pass = 0;
    att::BlockRef<bf16_t, bf16_t> cur = mix_ref(p, L, 0);
    att::Seam<bf16_t> S;
    att::causal_swa_prime<bf16_t, bf16_t>(cur, W, lds, S);
    for (;;) {
        const bool more_pass = pass == 0, more_item = L + stride < total, last = !more_pass && !more_item;
        int passn = pass + 1, Ln = L;
        if (!more_pass) { passn = 0; Ln = more_item ? L + stride : L; }
        const att::BlockRef<bf16_t, bf16_t> nxt = last ? cur : mix_ref(p, Ln, passn);
        att::causal_swa_block<MODE, bf16_t, bf16_t>(cur, nxt, SEQ, W, lds, S);
        if (last) break;
        cur = nxt; pass = passn; L = Ln;
    }
}
DI void f_mixers(const Params& p, LAS unsigned char* lds_) {
    char* lds = (char*)lds_;
    mix_stream<1>(p, lds, 0, N_RET_ITEMS);
    __syncthreads();
    mix_stream<0>(p, lds, N_RET_ITEMS, N_RET_ITEMS + N_ATT_ITEMS);
}

namespace mx {
using namespace att;
constexpr int LTAB = 100352;
constexpr int LK0 = 0, LV0 = 32768, LWS = 98304;
struct Blk { const bf16_t* Q; const bf16_t* K; const bf16_t* V; bf16_t* O; unsigned char* O8; const unsigned* k2; int P0, jlo; float lg; const bf16_t* s0; const bf16_t* G; const float* gain; float lam; };

template <int B>
DI void pv256(f32x16* o, int vb0, bf16x8 pa0, bf16x8 pa1, bf16x8 pa2, bf16x8 pa3) {
#define MX_TR(dst, off) asm volatile("ds_read_b64_tr_b16 %0, %1 offset:%2" : "=&v"(dst) : "v"(vb0), "i"(off) : "memory")
#define MX_LOAD(S, d) do { constexpr int b_ = B * 32768 + ((d) >> 2) * 16384 + ((d) & 3) * 512; MX_TR(S##l0, b_); MX_TR(S##h0, b_ + 2048); MX_TR(S##l1, b_ + 4096); MX_TR(S##h1, b_ + 6144); \
        MX_TR(S##l2, b_ + 8192); MX_TR(S##h2, b_ + 10240); MX_TR(S##l3, b_ + 12288); MX_TR(S##h3, b_ + 14336); } while (0)
#define MX_MMA(S, d) do { \
        o[d] = __builtin_amdgcn_mfma_f32_32x32x16_bf16(pa0, (bf16x8){S##l0[0], S##l0[1], S##l0[2], S##l0[3], S##h0[0], S##h0[1], S##h0[2], S##h0[3]}, o[d], 0, 0, 0); \
        o[d] = __builtin_amdgcn_mfma_f32_32x32x16_bf16(pa1, (bf16x8){S##l1[0], S##l1[1], S##l1[2], S##l1[3], S##h1[0], S##h1[1], S##h1[2], S##h1[3]}, o[d], 0, 0, 0); \
        o[d] = __builtin_amdgcn_mfma_f32_32x32x16_bf16(pa2, (bf16x8){S##l2[0], S##l2[1], S##l2[2], S##l2[3], S##h2[0], S##h2[1], S##h2[2], S##h2[3]}, o[d], 0, 0, 0); \
        o[d] = __builtin_amdgcn_mfma_f32_32x32x16_bf16(pa3, (bf16x8){S##l3[0], S##l3[1], S##l3[2], S##l3[3], S##h3[0], S##h3[1], S##h3[2], S##h3[3]}, o[d], 0, 0, 0); } while (0)
#define MX_WAIT() do { asm volatile("s_waitcnt lgkmcnt(0)" ::: "memory"); SBAR(); } while (0)
    s16x4 Al0, Ah0, Al1, Ah1, Al2, Ah2, Al3, Ah3, Bl0, Bh0, Bl1, Bh1, Bl2, Bh2, Bl3, Bh3;
    MX_LOAD(A, 0); MX_WAIT();
    MX_LOAD(B, 1); MX_MMA(A, 0); MX_WAIT();
    MX_LOAD(A, 2); MX_MMA(B, 1); MX_WAIT();
    MX_LOAD(B, 3); MX_MMA(A, 2); MX_WAIT();
    MX_LOAD(A, 4); MX_MMA(B, 3); MX_WAIT();
    MX_LOAD(B, 5); MX_MMA(A, 4); MX_WAIT();
    MX_LOAD(A, 6); MX_MMA(B, 5); MX_WAIT();
    MX_LOAD(B, 7); MX_MMA(A, 6); MX_WAIT();
    MX_MMA(B, 7);
#undef MX_TR
#undef MX_LOAD
#undef MX_MMA
#undef MX_WAIT
}
template <int KB>
DI void qk_first(const char* K_lds, u32x4 kbv, bf16x8& x0, bf16x8& y0, bf16x8& x1, bf16x8& y1) {
    const char* kt = K_lds + KB * SHM_K; const int k0 = (int)kbv[0], k1 = (int)kbv[1];
    x0 = *reinterpret_cast<const bf16x8*>(kt + k0); y0 = *reinterpret_cast<const bf16x8*>(kt + k0 + 32 * 256); x1 = *reinterpret_cast<const bf16x8*>(kt + k1); y1 = *reinterpret_cast<const bf16x8*>(kt + k1 + 32 * 256);
}
template <int KB>
DI void qkt4(f32x16& p0, f32x16& p1, const char* K_lds, u32x4 kbv, const bf16x8* qr, bf16x8 f0, bf16x8 f1, bf16x8 f2, bf16x8 f3) {
    p0 = f32x16{}; p1 = f32x16{};
    int kb[4];
#pragma unroll
    for (int dd = 0; dd < 4; ++dd) kb[dd] = (int)kbv[dd];
    const char* kt = K_lds + KB * SHM_K;
#pragma unroll
    for (int g = 0; g < 4; ++g) { const char* a0 = kt + (kb[(2 * g) & 3] ^ (((2 * g) >> 2) * 128)); const char* a1 = kt + (kb[(2 * g + 1) & 3] ^ (((2 * g + 1) >> 2) * 128));
        bf16x8 x0, y0, x1, y1;
        if (g == 0) { x0 = f0; y0 = f1; x1 = f2; y1 = f3; }
        else { x0 = *reinterpret_cast<const bf16x8*>(a0); y0 = *reinterpret_cast<const bf16x8*>(a0 + 32 * 256); x1 = *reinterpret_cast<const bf16x8*>(a1); y1 = *reinterpret_cast<const bf16x8*>(a1 + 32 * 256); }
        SBAR();
        p0 = __builtin_amdgcn_mfma_f32_32x32x16_bf16(x0, qr[2 * g], p0, 0, 0, 0); p1 = __builtin_amdgcn_mfma_f32_32x32x16_bf16(y0, qr[2 * g], p1, 0, 0, 0);
        p0 = __builtin_amdgcn_mfma_f32_32x32x16_bf16(x1, qr[2 * g + 1], p0, 0, 0, 0); p1 = __builtin_amdgcn_mfma_f32_32x32x16_bf16(y1, qr[2 * g + 1], p1, 0, 0, 0);
        SBAR(); }
}
DI bf16x8 pk8(const f32x16& P, int B_) {
    unsigned a0 = cvtpk(P[B_ + 0], P[B_ + 1]), a1 = cvtpk(P[B_ + 2], P[B_ + 3]), b0 = cvtpk(P[B_ + 4], P[B_ + 5]), b1 = cvtpk(P[B_ + 6], P[B_ + 7]);
    auto r0 = __builtin_amdgcn_permlane32_swap(a0, b0, false, false); auto r1 = __builtin_amdgcn_permlane32_swap(a1, b1, false, false);
    u32x4 w = {r0[0], r1[0], r0[1], r1[1]}; return *reinterpret_cast<bf16x8*>(&w);
}
template <int KB>
DI void qk_first_h0(const char* K_lds, u32x4 kbv, bf16x8& f0, bf16x8& f1, bf16x8& f2, bf16x8& f3) {
    const char* kt = K_lds + KB * SHM_K;
    f0 = *reinterpret_cast<const bf16x8*>(kt + (int)kbv[0]); f1 = *reinterpret_cast<const bf16x8*>(kt + (int)kbv[1]); f2 = *reinterpret_cast<const bf16x8*>(kt + (int)kbv[2]); f3 = *reinterpret_cast<const bf16x8*>(kt + (int)kbv[3]);
}
template <int KB>
DI void qk_att(f32x16& p0, f32x16& p1, const char* K_lds, u32x4 kbv, const bf16x8* qr, bf16x8 f0, bf16x8 f1, bf16x8 f2, bf16x8 f3, float nmb, float& ps, bf16x8& pa0, bf16x8& pa1) {
    constexpr float C2 = 1.4426950408889634f * SCALE;
    const char* kt = K_lds + KB * SHM_K;
#define MX_KF(d0, half) (*reinterpret_cast<const bf16x8*>(kt + (((d0) >> 2) ? ((int)kbv[(d0) & 3] ^ 128) : (int)kbv[(d0) & 3]) + (half) * 8192))
    const bf16x8 b0 = MX_KF(4, 0), b1 = MX_KF(5, 0), b2 = MX_KF(6, 0), b3 = MX_KF(7, 0);
    SBAR();
    p0 = f32x16{};
    p0 = __builtin_amdgcn_mfma_f32_32x32x16_bf16(f0, qr[0], p0, 0, 0, 0); p0 = __builtin_amdgcn_mfma_f32_32x32x16_bf16(f1, qr[1], p0, 0, 0, 0);
    p0 = __builtin_amdgcn_mfma_f32_32x32x16_bf16(f2, qr[2], p0, 0, 0, 0); p0 = __builtin_amdgcn_mfma_f32_32x32x16_bf16(f3, qr[3], p0, 0, 0, 0);
    SBAR();
    const bf16x8 c0 = MX_KF(0, 1), c1 = MX_KF(1, 1), c2 = MX_KF(2, 1), c3 = MX_KF(3, 1);
    SBAR();
    p0 = __builtin_amdgcn_mfma_f32_32x32x16_bf16(b0, qr[4], p0, 0, 0, 0); p0 = __builtin_amdgcn_mfma_f32_32x32x16_bf16(b1, qr[5], p0, 0, 0, 0);
    p0 = __builtin_amdgcn_mfma_f32_32x32x16_bf16(b2, qr[6], p0, 0, 0, 0); p0 = __builtin_amdgcn_mfma_f32_32x32x16_bf16(b3, qr[7], p0, 0, 0, 0);
    SBAR();
    const bf16x8 d0 = MX_KF(4, 1), d1 = MX_KF(5, 1), d2 = MX_KF(6, 1), d3 = MX_KF(7, 1);
    SBAR();
    p1 = f32x16{};
    p1 = __builtin_amdgcn_mfma_f32_32x32x16_bf16(c0, qr[0], p1, 0, 0, 0); p1 = __builtin_amdgcn_mfma_f32_32x32x16_bf16(c1, qr[1], p1, 0, 0, 0);
    p1 = __builtin_amdgcn_mfma_f32_32x32x16_bf16(c2, qr[2], p1, 0, 0, 0); p1 = __builtin_amdgcn_mfma_f32_32x32x16_bf16(c3, qr[3], p1, 0, 0, 0);
#pragma unroll
    for (int r = 0; r < 16; ++r) p0[r] = fmaf(p0[r], C2, nmb);
    SBAR();
    p1 = __builtin_amdgcn_mfma_f32_32x32x16_bf16(d0, qr[4], p1, 0, 0, 0); p1 = __builtin_amdgcn_mfma_f32_32x32x16_bf16(d1, qr[5], p1, 0, 0, 0);
    p1 = __builtin_amdgcn_mfma_f32_32x32x16_bf16(d2, qr[6], p1, 0, 0, 0); p1 = __builtin_amdgcn_mfma_f32_32x32x16_bf16(d3, qr[7], p1, 0, 0, 0);
#pragma unroll
    for (int r = 0; r < 16; ++r) { p0[r] = __builtin_amdgcn_exp2f(p0[r]); ps += p0[r]; }
    pa0 = pk8(p0, 0); pa1 = pk8(p0, 8);
    SBAR();
#undef MX_KF
}
DI void sm_bound_first(f32x16& p0, f32x16& p1, float nmb) {
    constexpr float C2 = 1.4426950408889634f * SCALE;
#pragma unroll
    for (int r = 0; r < 16; ++r) p0[r] = fmaf(p0[r], C2, nmb);
#pragma unroll
    for (int r = 0; r < 16; ++r) p0[r] = __builtin_amdgcn_exp2f(p0[r]);
}
template <int MODE, int EPI>
DI void block(const Blk& c, char* lds) {
    int tid_ = threadIdx.x; asm volatile("" : "+v"(tid_));
    const int tid = tid_, wid = __builtin_amdgcn_readfirstlane(tid >> 6), lane = tid & 63, r32 = lane & 31, hi = lane >> 5;
    char* K_lds = lds + LK0;
    const int vb0 = (int)(uintptr_t)(lds + LV0) + v_rd_base(lane);
    float* ws = (float*)(lds + LWS) + wid * 64; float* li_l = ws; float* al_l = ws + 32;
    unsigned koff[2], voff[4];
#pragma unroll
    for (int i = 0; i < 2; ++i) { const int o = (wid + 8 * i) * 1024 + lane * 16, row = o >> 8, cb = o & 255; koff[i] = (unsigned)(row * (LD * 2) + (cb ^ ((row & 15) << 4))); }
#pragma unroll
    for (int i = 0; i < 4; ++i) { const int q = wid + 8 * i, vh = q >> 4, sub = 2 * (q & 15) + (lane >> 5), kk = (sub >> 2) * 8 + ((lane & 31) >> 2), k = (kk & ~0xC) | ((kk & 4) << 1) | ((kk & 8) >> 1);
        voff[i] = (unsigned)(k * (LD * 2) + (vh * 128 + (sub & 3) * 32 + (lane & 3) * 8) * 2); }
    const int tabp = (int)(uintptr_t)(lds + LTAB) + tid * 48;
    { u32x4 kb4;
#pragma unroll
      for (int dd = 0; dd < 4; ++dd) kb4[dd] = (unsigned)(r32 * 256 + (((dd * 2 + hi) ^ (r32 & 15)) << 4));
      const u32x4 vo4 = {voff[0], voff[1], voff[2], voff[3]}; const u32x2 ko2 = {koff[0], koff[1]};
      asm volatile("ds_write_b128 %0, %1\n\tds_write_b128 %0, %2 offset:16\n\tds_write_b64 %0, %3 offset:32\n\ts_waitcnt lgkmcnt(0)" :: "v"(tabp), "v"(vo4), "v"(kb4), "v"(ko2) : "memory"); }
    const int j_lo = c.jlo, NT = (c.P0 + QB - 1) / KVBLK + 1 - j_lo;
    const int qlo = c.P0 + wid * QBLK, nvis = (qlo >> 6) - j_lo + 1;
#define MX_STAGE(t, b) do { u32x4 vo_; u32x2 ko_; asm volatile("ds_read_b128 %0, %2\n\tds_read_b64 %1, %2 offset:32\n\ts_waitcnt lgkmcnt(0)" : "=&v"(vo_), "=&v"(ko_) : "v"(tabp) : "memory"); const char* kt_ = (const char*)c.K + (size_t)(j_lo + (t)) * (KVBLK * LD * 2); const char* vt_ = (const char*)c.V + (size_t)(j_lo + (t)) * (KVBLK * LD * 2); \
        _Pragma("unroll") for (int i_ = 0; i_ < 2; ++i_) __builtin_amdgcn_global_load_lds((const unsigned*)(kt_ + ko_[i_]), (LAS unsigned*)(lds + LK0 + (b) * 16384 + (wid + 8 * i_) * 1024), 16, 0, 0); \
        _Pragma("unroll") for (int i_ = 0; i_ < 4; ++i_) __builtin_amdgcn_global_load_lds((const unsigned*)(vt_ + vo_[i_]), (LAS unsigned*)(lds + LV0 + (b) * 32768 + (wid + 8 * i_) * 1024), 16, 0, 0); } while (0)
    MX_STAGE(0, 0);
    bf16x8 qr[8];
#pragma unroll
    for (int d0 = 0; d0 < 8; ++d0) qr[d0] = *reinterpret_cast<const bf16x8*>(c.Q + (size_t)(wid * QBLK + r32) * LD + d0 * 16 + hi * 8);
    float m_reg = -1e30f, l_reg = 0.f, nmb = 0.f; f32x16 o[8];
    if constexpr (MODE == 0) { float q2 = 0.f;
#pragma unroll
        for (int d0 = 0; d0 < 8; ++d0)
#pragma unroll
            for (int e = 0; e < 8; ++e) { const float f = bf2f((unsigned)(unsigned short)qr[d0][e]); q2 += f * f; }
        { auto rr = __builtin_amdgcn_permlane32_swap(__float_as_uint(q2), __float_as_uint(q2), false, false); q2 = __uint_as_float(rr[0]) + __uint_as_float(rr[1]); }
        const float k2 = (__uint_as_float(c.k2[0]) + __uint_as_float(c.k2[1])) + (__uint_as_float(c.k2[2]) + __uint_as_float(c.k2[3]));
        nmb = -(sqrtf(q2 * k2) * (1.4426950408889634f * SCALE * 1.02f) + 0.01f); }
#pragma unroll
    for (int d = 0; d < 8; ++d)
#pragma unroll
        for (int r = 0; r < 16; ++r) o[d][r] = 0.f;
    if constexpr (MODE == 1) { if (c.s0) {
#pragma unroll
        for (int dv = 0; dv < 8; ++dv)
#pragma unroll
            for (int st = 0; st < 8; ++st) { const bf16x8 sf = *reinterpret_cast<const bf16x8*>(c.s0 + (size_t)(dv * 32 + r32) * 128 + st * 16 + hi * 8); o[dv] = __builtin_amdgcn_mfma_f32_32x32x16_bf16(qr[st], sf, o[dv], 0, 0, 0); if (st == 7 && (dv & 1)) SBAR(); }
#pragma unroll
        for (int r = 0; r < 16; ++r) { const float f = __builtin_amdgcn_exp2f(c.lg * (float)(qlo + att::crow(r, hi) - j_lo * KVBLK + 1));
#pragma unroll
            for (int dv = 0; dv < 8; ++dv) o[dv][r] *= f; } } }
    if (wid >= 4) __builtin_amdgcn_s_setprio(1);
    asm volatile("s_waitcnt vmcnt(0)" ::: "memory"); __syncthreads();
#define MX_TRD(dst, off) asm volatile("ds_read_b64_tr_b16 %0, %1 offset:%2" : "=&v"(dst) : "v"(vbx_), "i"(off) : "memory")
#define MX_LDH(S, d, KH) do { constexpr int b_ = ((d) >> 2) * 16384 + ((d) & 3) * 512 + (KH) * 8192; MX_TRD(S##a, b_); MX_TRD(S##b, b_ + 2048); MX_TRD(S##c, b_ + 4096); MX_TRD(S##e, b_ + 6144); } while (0)
#define MX_MM2(S, d, PA, PB) do { \
        o[d] = __builtin_amdgcn_mfma_f32_32x32x16_bf16(PA, (bf16x8){S##a[0], S##a[1], S##a[2], S##a[3], S##b[0], S##b[1], S##b[2], S##b[3]}, o[d], 0, 0, 0); \
        o[d] = __builtin_amdgcn_mfma_f32_32x32x16_bf16(PB, (bf16x8){S##c[0], S##c[1], S##c[2], S##c[3], S##e[0], S##e[1], S##e[2], S##e[3]}, o[d], 0, 0, 0); } while (0)
#define MX_LW(n) do { asm volatile("s_waitcnt lgkmcnt(" #n ")" ::: "memory"); SBAR(); } while (0)
#define MX_PASS(KH, PA, PB, F) do { \
        MX_LDH(S0, 0, KH); \
        MX_LDH(S1, 1, KH); MX_LW(4); MX_MM2(S0, 0, PA, PB); F(0); SBAR(); \
        MX_LDH(S0, 2, KH); MX_LW(4); MX_MM2(S1, 1, PA, PB); F(1); SBAR(); \
        MX_LDH(S1, 3, KH); MX_LW(4); MX_MM2(S0, 2, PA, PB); F(2); SBAR(); \
        MX_LDH(S0, 4, KH); MX_LW(4); MX_MM2(S1, 3, PA, PB); F(3); SBAR(); \
        MX_LDH(S1, 5, KH); MX_LW(4); MX_MM2(S0, 4, PA, PB); F(4); SBAR(); \
        MX_LDH(S0, 6, KH); MX_LW(4); MX_MM2(S1, 5, PA, PB); F(5); SBAR(); \
        MX_LDH(S1, 7, KH); MX_LW(4); MX_MM2(S0, 6, PA, PB); F(6); SBAR(); \
        MX_LW(0); MX_MM2(S1, 7, PA, PB); F(7); SBAR(); } while (0)
#define MX_F1(d) do { p1[2 * (d)] = __builtin_amdgcn_exp2f(fmaf(p1[2 * (d)], 1.4426950408889634f * SCALE, nmb)); p1[2 * (d) + 1] = __builtin_amdgcn_exp2f(fmaf(p1[2 * (d) + 1], 1.4426950408889634f * SCALE, nmb)); ps_ += p1[2 * (d)] + p1[2 * (d) + 1]; } while (0)
#define MX_F0(d) do { } while (0)
#define MX_ATT(b) do { const int vbx_ = vb0 + (b) * 32768; s16x4 S0a, S0b, S0c, S0e, S1a, S1b, S1c, S1e; float ps_ = 0.f; \
        qk_att<(b)>(p0, p1, K_lds, kbv_, qr, kf0, kf1, kf2, kf3, nmb, ps_, pa0, pa1); \
        MX_PASS(0, pa0, pa1, MX_F1); \
        pa2 = pk8(p1, 0); pa3 = pk8(p1, 8); \
        { auto rr = __builtin_amdgcn_permlane32_swap(__float_as_uint(ps_), __float_as_uint(ps_), false, false); l_reg += __uint_as_float(rr[0]) + __uint_as_float(rr[1]); } SBAR(); \
        MX_PASS(1, pa2, pa3, MX_F0); } while (0)
#define MX_TILE(t, b) do { bf16x8 kf0, kf1, kf2, kf3; u32x4 kbv_; asm volatile("ds_read_b128 %0, %1 offset:16\n\ts_waitcnt lgkmcnt(0)" : "=&v"(kbv_) : "v"(tabp) : "memory"); if constexpr (MODE == 0) qk_first_h0<(b)>(K_lds, kbv_, kf0, kf1, kf2, kf3); else qk_first<(b)>(K_lds, kbv_, kf0, kf1, kf2, kf3); SBAR();     \
        if ((t) + 1 < NT) MX_STAGE((t) + 1, (b) ^ 1); \
        if ((t) < nvis) { f32x16 p0, p1; float mn, al; bf16x8 pa0, pa1, pa2, pa3; const float fd = (float)(qlo + r32 - 4 * hi - (j_lo + (t)) * KVBLK); \
            if constexpr (MODE == 0) { MX_ATT(b); } \
            else { qkt4<(b)>(p0, p1, K_lds, kbv_, qr, kf0, kf1, kf2, kf3); partialSM<MODE>(p0, p1, m_reg, mn, al, fd, c.lg); finishSM<MODE>(p0, p1, al, l_reg, pa0, pa1, pa2, pa3, fd, c.lg); SBAR(); pv256<(b)>(o, vb0, pa0, pa1, pa2, pa3); } } \
        asm volatile("s_waitcnt vmcnt(0)" ::: "memory"); __syncthreads(); } while (0)
    for (int t = 0; t < NT; t += 2) { MX_TILE(t, 0); if (t + 1 < NT) MX_TILE(t + 1, 1); }
    __builtin_amdgcn_s_setprio(0);
    float rli[16];
    if constexpr (MODE == 0) { if (hi == 0) li_l[r32] = l_reg; asm volatile("s_waitcnt lgkmcnt(0)" ::: "memory");
#pragma unroll
        for (int r = 0; r < 16; ++r) rli[r] = __builtin_amdgcn_rcpf(li_l[att::crow(r, hi)]); }
    else {
#pragma unroll
        for (int r = 0; r < 16; ++r) rli[r] = 1.f; }
    { float* st = (float*)(lds + wid * 8192); const int cg = lane & 31, rs = lane >> 5;
      f32x4 g0 = {1.f, 1.f, 1.f, 1.f}, g1 = g0;
      u32x4 gq[4] = {};
      if constexpr (EPI != 0) { g0 = *(const f32x4*)(c.gain + cg * 8); g1 = *(const f32x4*)(c.gain + cg * 8 + 4);
#pragma unroll
          for (int j = 0; j < 4; ++j) { const u32x4* gp_ = (const u32x4*)(c.G + (size_t)(wid * QBLK + rs + 2 * j) * LD + cg * 8); if constexpr (EPI == 1) gq[j] = __builtin_nontemporal_load(gp_); else gq[j] = *gp_; } }
#pragma unroll 1
      for (int g = 0; g < 4; ++g) {
          u32x4 gn[4] = {};
          if constexpr (EPI != 0) { const int gx = g < 3 ? g + 1 : 3;
#pragma unroll
              for (int j = 0; j < 4; ++j) { const u32x4* gp_ = (const u32x4*)(c.G + (size_t)(wid * QBLK + 8 * gx + rs + 2 * j) * LD + cg * 8); if constexpr (EPI == 1) gn[j] = __builtin_nontemporal_load(gp_); else gn[j] = *gp_; } }
#pragma unroll
          for (int d = 0; d < 8; ++d)
#pragma unroll
              for (int rr = 0; rr < 4; ++rr) { float v = 0.f;
#pragma unroll
                  for (int gg = 0; gg < 4; ++gg) if (gg == g) v = o[d][4 * gg + rr] * rli[4 * gg + rr];
                  st[(rr + 4 * hi) * 256 + d * 32 + r32] = v; }
          asm volatile("s_waitcnt lgkmcnt(0)" ::: "memory");
#pragma unroll
          for (int j = 0; j < 4; ++j) { const int lr = rs + 2 * j; const size_t trow = (size_t)(wid * QBLK + 8 * g + lr);
              const f32x4 xa = *(const f32x4*)(st + lr * 256 + cg * 8), xb = *(const f32x4*)(st + lr * 256 + cg * 8 + 4);
              float x[8] = {xa[0], xa[1], xa[2], xa[3], xb[0], xb[1], xb[2], xb[3]}, y[8];
              if constexpr (EPI == 0) {
#pragma unroll
                  for (int k = 0; k < 8; ++k) y[k] = x[k]; }
              else if constexpr (EPI == 1) { float gt[8]; unpack8(gq[j], gt);
                  float s = 0.f;
#pragma unroll
                  for (int k = 0; k < 8; ++k) s += x[k];
                  const float mean = half_sum(s) * (1.f / 256.f); float q = 0.f;
#pragma unroll
                  for (int k = 0; k < 8; ++k) { x[k] -= mean; q += x[k] * x[k]; }
                  const float rstd = rsqrtf(half_sum(q) * (1.f / 256.f) + LN_EPS);
#pragma unroll
                  for (int k = 0; k < 8; ++k) y[k] = x[k] * rstd * (k < 4 ? g0[k & 3] : g1[k & 3]) * (gt[k] * sigmoidf_(gt[k])); }
              else { float pv[8]; unpack8(gq[j], pv);
                  float ms = 0.f;
#pragma unroll
                  for (int k = 0; k < 8; ++k) { x[k] = pv[k] - c.lam * x[k]; ms += x[k] * x[k]; }
                  const float rsn = rsqrtf(half_sum(ms) * (1.f / 256.f) + LN_EPS) * (1.f - LAMBDA_INIT);
#pragma unroll
                  for (int k = 0; k < 8; ++k) y[k] = x[k] * rsn * (k < 4 ? g0[k & 3] : g1[k & 3]); }
              if constexpr (PROJ_FP8 && EPI != 0) *(u32x2*)(c.O8 + trow * LD + cg * 8) = (u32x2){pk4_fp8(y[0] * F8_SX, y[1] * F8_SX, y[2] * F8_SX, y[3] * F8_SX), pk4_fp8(y[4] * F8_SX, y[5] * F8_SX, y[6] * F8_SX, y[7] * F8_SX)};
              else *(u32x4*)(c.O + trow * LD + cg * 8) = (u32x4){cvtpk(y[0], y[1]), cvtpk(y[2], y[3]), cvtpk(y[4], y[5]), cvtpk(y[6], y[7])}; }
#pragma unroll
          for (int j = 0; j < 4; ++j) gq[j] = gn[j];
          asm volatile("s_waitcnt lgkmcnt(0)" ::: "memory"); } }
    __syncthreads();
#undef MX_STAGE
#undef MX_TRD
#undef MX_LDH
#undef MX_MM2
#undef MX_LW
#undef MX_PASS
#undef MX_F1
#undef MX_F0
#undef MX_ATT
#undef MX_TILE
}
}
DI void f_mixers256(const Params& p, LAS unsigned char* lds_) {
    char* lds = (char*)lds_; unsigned char* ws = p.ws;
    const int G = gridDim.x, vcu = (G % 8 == 0) ? (blockIdx.x % 8) * (G / 8) + blockIdx.x / 8 : blockIdx.x;
    const float lam = ((const float*)(ws + TAB_MISC))[0];
    for (int it = vcu; it < 256; it += G) { const int seg = it & 7, h = (it >> 3) & 7, b = it >> 6; const size_t t0 = (size_t)b * SEQ;
#pragma unroll 1
        for (int half = 0; half < 2; ++half) { const int qb = 2 * seg + half; mx::Blk k; const size_t r0 = (t0 + (size_t)qb * 256) * 2048 + h * 256;
            k.Q = (const bf16_t*)(ws + WS_RQ) + (t0 + (size_t)qb * 256) * 2048 + h * 128; k.K = (const bf16_t*)(ws + WS_RQ) + t0 * 2048 + 1024 + h * 128;
            k.V = (const bf16_t*)(ws + WS_RV) + t0 * 2048 + h * 256; k.O = (bf16_t*)p.out + r0; k.O8 = ws + WS_RETA8 + r0;
            k.P0 = qb * 256; k.jlo = seg * 8; k.lg = log2f(1.f - exp2f(-5.f - (float)h));
            k.s0 = seg ? (const bf16_t*)p.out + (size_t)32 * MiB + (size_t)((b * 8 + h) * 7 + seg - 1) * 256 * 128 : nullptr;
            k.G = (const bf16_t*)(ws + WS_RG) + r0; k.gain = p.ret_gn + h * 256; k.lam = 0.f;
            mx::block<1, 1>(k, lds); } }
    for (int it = vcu; it < 256; it += G) { const int x = it & 7, h = (it >> 3) & 7, b = it >> 6; const size_t t0 = (size_t)b * SEQ, hc = (size_t)h * 256;
#pragma unroll 1
        for (int j = 0; j < 4; ++j) { const int i = j & 1, qb = (j >> 1) ? 15 - x : x; mx::Blk k; const size_t r0 = (t0 + (size_t)qb * 256) * 2048 + hc;
            k.Q = (const bf16_t*)(ws + WS_DQ) + r0 + i * 128; k.K = (const bf16_t*)(ws + WS_DK) + t0 * 2048 + hc + i * 128;
            k.V = (const bf16_t*)(ws + WS_DV) + t0 * 2048 + hc;
            k.P0 = qb * 256; k.jlo = 0; k.lg = 0.f; k.s0 = nullptr; k.G = (const bf16_t*)(ws + WS_O0) + r0; k.gain = p.subln; k.lam = lam;
            k.O8 = ws + WS_DIFFA8 + r0; k.k2 = (const unsigned*)(ws + CW_K2) + ((b * 8 + h) * 2 + i) * 4;
            if (i == 0) { k.O = (bf16_t*)(ws + WS_O0) + r0; mx::block<0, 0>(k, lds); }
            else { k.O = (bf16_t*)(ws + WS_DIFFA) + r0; mx::block<0, 2>(k, lds); } } }
}
typedef short s16x4_t __attribute__((ext_vector_type(4)));
DI void tr_read4(s16x4_t& a, s16x4_t& b, s16x4_t& c, s16x4_t& d, unsigned pa, unsigned pb, unsigned pc, unsigned pd) {
    asm volatile("ds_read_b64_tr_b16 %0, %4\n\tds_read_b64_tr_b16 %1, %5\n\tds_read_b64_tr_b16 %2, %6\n\tds_read_b64_tr_b16 %3, %7\n\ts_waitcnt lgkmcnt(0)"
                 : "=&v"(a), "=&v"(b), "=&v"(c), "=&v"(d) : "v"(pa), "v"(pb), "v"(pc), "v"(pd) : "memory");
}
DI void phase_ret_state(const Params& p, LAS unsigned char* lds) {
    const int tid = threadIdx.x, lane = tid & 63, w = tid >> 6, r32 = lane & 31, hi = lane >> 5;
    const bf16_t* rqk = (const bf16_t*)(p.ws + WS_RQ); const bf16_t* rv = (const bf16_t*)(p.ws + WS_RV);
    bf16_t* s0t = (bf16_t*)p.out + (size_t)32 * MiB;
    constexpr int KB_ = 16384, VB_ = 8192, BUF = KB_ + VB_;
    for (int U = blockIdx.x; U < 128; U += gridDim.x) { const int dvs = U & 3, h = (U >> 2) & 7, b = U >> 5, dvt = w & 1, dkt = w >> 1;
        const float lg = log2f(1.f - exp2f(-5.f - (float)h)), g64 = exp2f(lg * 64.f);
        const bf16_t* kg = rqk + (size_t)b * SEQ * 2048 + 1024 + h * 128; const bf16_t* vg = rv + (size_t)b * SEQ * 2048 + h * 256 + dvs * 64;
        const int kt0 = tid >> 4, kc = tid & 15, vt = tid >> 3, vc = tid & 7;
        const float d0 = exp2f(lg * (float)(63 - kt0)), d1 = exp2f(lg * (float)(63 - kt0 - 32));
        u32x4 rk0 = *(const u32x4*)(kg + (size_t)kt0 * 2048 + kc * 8), rk1 = *(const u32x4*)(kg + (size_t)(kt0 + 32) * 2048 + kc * 8), rvv = *(const u32x4*)(vg + (size_t)vt * 2048 + vc * 8);
        f32x16 acc;
#pragma unroll
        for (int q = 0; q < 16; ++q) acc[q] = 0.f;
        const int i16 = lane & 15, tq = i16 >> 2, tp = i16 & 3, grp = (lane >> 4) & 1;
        const unsigned lbase = (unsigned)(size_t)lds;
        const unsigned aV = lbase + KB_ + (unsigned)((8 * hi + tq) * 128 + (dvt * 32 + 16 * grp + 4 * tp) * 2);
        const unsigned aK = lbase + (unsigned)((8 * hi + tq) * 256 + (dkt * 32 + 16 * grp + 4 * tp) * 2);
        for (int c = 0; c < 56; ++c) { const unsigned bo = (unsigned)(c & 1) * BUF;
            { float f[8]; unpack8(rk0, f); *(LAS u32x4*)(lds + bo + kt0 * 256 + kc * 16) = (u32x4){pk2(f[0] * d0, f[1] * d0), pk2(f[2] * d0, f[3] * d0), pk2(f[4] * d0, f[5] * d0), pk2(f[6] * d0, f[7] * d0)};
              unpack8(rk1, f); *(LAS u32x4*)(lds + bo + (kt0 + 32) * 256 + kc * 16) = (u32x4){pk2(f[0] * d1, f[1] * d1), pk2(f[2] * d1, f[3] * d1), pk2(f[4] * d1, f[5] * d1), pk2(f[6] * d1, f[7] * d1)};
              *(LAS u32x4*)(lds + bo + KB_ + vt * 128 + vc * 16) = rvv; }
            if (c + 1 < 56) { const size_t t1 = (size_t)(c + 1) * 64; rk0 = *(const u32x4*)(kg + (t1 + kt0) * 2048 + kc * 8); rk1 = *(const u32x4*)(kg + (t1 + kt0 + 32) * 2048 + kc * 8); rvv = *(const u32x4*)(vg + (t1 + vt) * 2048 + vc * 8); }
            __syncthreads();
#pragma unroll
            for (int q = 0; q < 16; ++q) acc[q] *= g64;
#pragma unroll
            for (int ks = 0; ks < 4; ++ks) { s16x4_t v0, v1, k0, k1;
                tr_read4(v0, v1, k0, k1, aV + bo + ks * 16 * 128, aV + bo + (ks * 16 + 4) * 128, aK + bo + ks * 16 * 256, aK + bo + (ks * 16 + 4) * 256);
                const bf16x8 af = {v0[0], v0[1], v0[2], v0[3], v1[0], v1[1], v1[2], v1[3]}, bfv = {k0[0], k0[1], k0[2], k0[3], k1[0], k1[1], k1[2], k1[3]};
                acc = MFMA32(af, bfv, acc); }
            if ((c & 7) == 7) { const int s = c >> 3;
#pragma unroll
                for (int q = 0; q < 16; ++q) s0t[((size_t)((b * 8 + h) * 7 + s) * 256 + dvs * 64 + dvt * 32 + crow(q, hi)) * 128 + dkt * 32 + r32] = (bf16_t)f2bf(acc[q]); }
        }
        __syncthreads();
    }
}

#define XB_TMO      128
#define XB_XCNT(j)  (256  + 64 * (j))
#define XB_XSUB(j)  (1280 + 64 * (j))
#define XB_XGEN(j)  (2304 + 64 * (j))
#define XB_TOP      3328
#define XB_TOPGEN   3392
#define XCD_BAR_WORDS 3456
#define XB_SPIN_CAP (1u << 18)

__device__ __forceinline__ unsigned xb_ld(unsigned* p)              { return __hip_atomic_load(p, __ATOMIC_RELAXED, __HIP_MEMORY_SCOPE_AGENT); }
__device__ __forceinline__ unsigned xb_add(unsigned* p, unsigned v) { return __hip_atomic_fetch_add(p, v, __ATOMIC_RELAXED, __HIP_MEMORY_SCOPE_AGENT); }
__device__ __forceinline__ unsigned xb_xcc_id() { return (unsigned)__builtin_amdgcn_s_getreg((3 << 11) | 20) & 0xFu; }
#define XB_SPIN(cond, bar) do { unsigned _sp = 0; while (cond) { __builtin_amdgcn_s_sleep(1); \
    if ((++_sp & 255u) == 0u) { if (xb_ld(&(bar)[XB_TMO])) break; if (_sp > XB_SPIN_CAP) { atomicAdd(&(bar)[XB_TMO], 1u); break; } } } } while (0)

struct XcdBarrier {
    unsigned* bar; unsigned x;
    volatile LAS unsigned* st;
};

__device__ __forceinline__ XcdBarrier xcd_barrier_post(unsigned* bar, volatile LAS unsigned* st) {
    XcdBarrier b; b.bar = bar; b.x = xb_xcc_id(); b.st = st;
    if (threadIdx.x == 0) (void)xb_add(&bar[XB_XCNT(b.x)], 1u);
    return b;
}
__device__ __forceinline__ void xcd_barrier_complete(unsigned* bar, unsigned x, unsigned& nloc, unsigned& nx) {
    const unsigned G = gridDim.x * gridDim.y * gridDim.z;
    unsigned sum, cnt, mine, sp = 0u;
    for (;;) {
        sum = 0u; cnt = 0u; mine = 0u;
#pragma unroll
        for (unsigned j = 0; j < 16; ++j) { const unsigned c = xb_ld(&bar[XB_XCNT(j)]); sum += c; cnt += (c > 0u) ? 1u : 0u; mine = (j == x) ? c : mine; }
        if (sum == G) break;
        __builtin_amdgcn_s_sleep(1);
        if ((++sp & 255u) == 0u) { if (xb_ld(&bar[XB_TMO])) break; if (sp > XB_SPIN_CAP) { atomicAdd(&bar[XB_TMO], 1u); break; } }
    }
    nloc = mine > 0u ? mine : 1u; nx = cnt > 0u ? cnt : 1u;
}

__device__ __forceinline__ void xcd_barrier(const XcdBarrier& b) {
    asm volatile("s_waitcnt vmcnt(0)" ::: "memory");
    __syncthreads();
    if (threadIdx.x == 0) {
        unsigned* bar = b.bar;
        __builtin_amdgcn_s_waitcnt(0);
        unsigned nloc = b.st[0], nx = b.st[1];
        if (nloc == 0u) { xcd_barrier_complete(bar, b.x, nloc, nx); b.st[0] = nloc; b.st[1] = nx; }
        const unsigned old = xb_add(&bar[XB_XSUB(b.x)], 1u);
        const unsigned gen = old / nloc;
        if (old + 1u == (gen + 1u) * nloc) {
            __builtin_amdgcn_fence(__ATOMIC_RELEASE, "agent");
            asm volatile("s_waitcnt vmcnt(0)" ::: "memory");
            const unsigned og = xb_add(&bar[XB_TOP], 1u);
            const unsigned tg = og / nx;
            if (og + 1u == (tg + 1u) * nx) xb_add(&bar[XB_TOPGEN], 1u);
            else XB_SPIN(xb_ld(&bar[XB_TOPGEN]) == tg, bar);
            __builtin_amdgcn_fence(__ATOMIC_ACQUIRE, "agent");
            xb_add(&bar[XB_XGEN(b.x)], 1u);
            asm volatile("s_waitcnt vmcnt(0)" ::: "memory");
        } else {
            XB_SPIN(xb_ld(&bar[XB_XGEN(b.x)]) == gen, bar);
            __builtin_amdgcn_fence(__ATOMIC_ACQUIRE, "agent");
            asm volatile("s_waitcnt vmcnt(0)" ::: "memory");
        }
    }
    __syncthreads();
}

constexpr int NPH = 11;
constexpr bool FAST_GEMM = true, FAST_MOE = true;
constexpr int LDS_BYTES = 147456;
constexpr int LDS_MISC = 131072 + 8192;
constexpr int CW_BAR = 4096;
template <int PH> DI void run_phase(const Params& p, LAS unsigned char* lds) {
    if constexpr (PH == 0) phase_prep(p, lds);
    if constexpr (PH == 1) { if constexpr (FAST_GEMM) f_inproj(p, lds); else n_inproj(p); }
    if constexpr (PH == 2) { if constexpr (MIX256) f_mixers256(p, lds); else if constexpr (FAST_ATTN) f_mixers(p, lds); else n_mixers(p, lds); }
    if constexpr (PH == 3) phase_norms(p);
    if constexpr (PH == 4) { if constexpr (FAST_GEMM) f_proj(p, lds); else n_proj(p); }
    if constexpr (PH == 5) { if constexpr (FAST_GEMM) f_outproj(p, lds); else n_outproj(p); }
    if constexpr (PH == 6) phase_ln1_router(p);
    if constexpr (PH == 7) {   }
    if constexpr (PH == 8) { if constexpr (FAST_MOE) f_moe_up(p, lds); else n_moe_up(p); }
    if constexpr (PH == 9) { if constexpr (FAST_MOE) f_moe_down(p, lds); else n_moe_down(p); }
    if constexpr (PH == 10) phase_final(p);
    if constexpr (PH == 11) { if constexpr (FAST_ATTN) { phase_ret_state(p, lds); prep_fill_rs(p, lds); } }
}
template <int LO, int HI> __global__ void __launch_bounds__(512, 2) k_range(Params p) {
    extern __shared__ __attribute__((aligned(16))) unsigned char lds_raw[];
    LAS unsigned char* lds = (LAS unsigned char*)lds_raw;
    XcdBarrier bar; bar.bar = nullptr; bar.x = 0; bar.st = nullptr;
    if constexpr (HI - LO > 1) {
        volatile LAS unsigned* misc = (volatile LAS unsigned*)(lds + LDS_MISC);
        if (threadIdx.x < 4) misc[threadIdx.x] = 0u;
        __syncthreads();
        bar = xcd_barrier_post((unsigned*)(p.ws + WS_CTL) + CW_BAR, misc);
    }
#ifndef REPEAT_MASK
#define REPEAT_MASK 0
#endif
#define PHASE(k) if constexpr (LO <= (k) && (k) < HI) { run_phase<(k)>(p, lds); if constexpr ((REPEAT_MASK >> (k)) & 1) { xcd_barrier(bar); run_phase<(k)>(p, lds); } if constexpr ((k) + 1 < HI) xcd_barrier(bar); }
    PHASE(0) PHASE(1) if constexpr (LO <= 1 && 2 < HI) { run_phase<11>(p, lds); xcd_barrier(bar); if constexpr ((REPEAT_MASK >> 11) & 1) { run_phase<11>(p, lds); xcd_barrier(bar); } } PHASE(2) PHASE(4) PHASE(5) PHASE(6) PHASE(8) PHASE(9) PHASE(10)
#undef PHASE
}
#ifndef N_LAUNCHES
#define N_LAUNCHES 1
#endif
template <int LO, int HI> static void launch_range(const Params& p, hipStream_t stream) {
    static int grid = 0;
    if (!grid) {
        (void)hipFuncSetAttribute((const void*)k_range<LO, HI>, hipFuncAttributeMaxDynamicSharedMemorySize, LDS_BYTES);
        int dev = 0, cus = 0, per_cu = 0; (void)hipGetDevice(&dev); (void)hipDeviceGetAttribute(&cus, hipDeviceAttributeMultiprocessorCount, dev);
        if (hipOccupancyMaxActiveBlocksPerMultiprocessor(&per_cu, (const void*)k_range<LO, HI>, 512, LDS_BYTES) != hipSuccess || per_cu < 1) { fprintf(stderr, "occupancy query: %d blocks per CU\n", per_cu); (void)hipGetLastError(); }
        grid = cus > 0 ? cus : 256;
    }
    hipLaunchKernelGGL((k_range<LO, HI>), dim3(grid), dim3(512), LDS_BYTES, stream, p);
}

extern "C" void kernel_launch(void* const* d_in, const int* in_sizes, int n_in, void* d_out, int out_size, void* d_ws, size_t ws_size, hipStream_t stream) {
    if (n_in != 23 || out_size != NTOK * DM || ws_size < WS_END) { fprintf(stderr, "kernel_launch: unexpected shapes (n_in %d out %d ws %zu need %zu)\n", n_in, out_size, ws_size, (size_t)WS_END); return; }
    Params p{};
    p.x = (const float*)d_in[0]; p.pos = (const int*)d_in[1]; p.w_in = (const float*)d_in[2]; p.ret_gn = (const float*)d_in[3];
    p.lq1 = (const float*)d_in[4]; p.lk1 = (const float*)d_in[5]; p.lq2 = (const float*)d_in[6]; p.lk2 = (const float*)d_in[7]; p.subln = (const float*)d_in[8];
    p.w_ret_proj = (const float*)d_in[9]; p.w_diff_proj = (const float*)d_in[10]; p.w_out = (const float*)d_in[11]; p.ln1g = (const float*)d_in[12]; p.ln1b = (const float*)d_in[13];
    p.w_group = (const float*)d_in[14]; p.b_group = (const float*)d_in[15]; p.w_router = (const float*)d_in[16]; p.b_router = (const float*)d_in[17];
    p.w_gate = (const float*)d_in[18]; p.w_up = (const float*)d_in[19]; p.w_down = (const float*)d_in[20]; p.ln2g = (const float*)d_in[21]; p.ln2b = (const float*)d_in[22];
    p.out = (float*)d_out; p.ws = (unsigned char*)d_ws;
    (void)hipMemsetAsync((char*)d_ws + WS_CTL, 0, 1 * MiB, stream);
#if N_LAUNCHES == 1
    launch_range<0, NPH>(p, stream);
#else
    launch_range<0, 1>(p, stream); launch_range<1, 2>(p, stream); launch_range<2, 3>(p, stream); launch_range<3, 4>(p, stream); launch_range<4, 5>(p, stream); launch_range<5, 6>(p, stream);
    launch_range<6, 7>(p, stream); launch_range<7, 8>(p, stream); launch_range<8, 9>(p, stream); launch_range<9, 10>(p, stream); launch_range<10, 11>(p, stream);
#endif
}
```
